# Optimizing an MI355X kernel written in HIP

```python
import jax, jax.numpy as jnp
from jax import lax
import numpy as np

D_MODEL = 1024
BATCH = 32
SEQ = 256
DEPTH = 4
DEC_BATCH = 8
DEC_SEQ = 2048
PAST_LEN = 256

GRID_W = 64
HEAD_DIM = 64
N_HEADS = D_MODEL // HEAD_DIM
H_RET = N_HEADS // 2
H_NA = N_HEADS - H_RET
RET_DK = HEAD_DIM
RET_DV = HEAD_DIM
RET_CHUNK = 128
WIN_R = 8
WIN_C = 16
NA_QB = 16
NA_KBW = NA_QB + WIN_C
NA_NCB = GRID_W // NA_QB
MLA_HEADS = N_HEADS
MLA_Q_LORA = 384
MLA_KV_LORA = 256
MLA_NOPE = 64
MLA_ROPE = 32
MLA_V = 64
MLA_SCALE = (MLA_NOPE + MLA_ROPE) ** -0.5
ROPE_BASE = 10000.0
D_FF = 4 * D_MODEL
Q_BLOCK = 128
N_A_LAYERS = (DEPTH + 1) // 2
N_C_LAYERS = DEPTH // 2
EPS = 1e-6
NEG_INF = -1e30
AC_IN = 2 * H_RET * RET_DK + 2 * H_RET * RET_DV + 3 * H_NA * HEAD_DIM
AC_OUT = H_RET * RET_DV + H_NA * HEAD_DIM
C_IN = MLA_Q_LORA + MLA_KV_LORA + MLA_ROPE

kernel_name = 'hybrid_retention_na_mla_flow_step'


def rms_norm(x, g):
    xf = x.astype(jnp.float32)
    y = xf * lax.rsqrt(jnp.mean(xf * xf, axis=-1, keepdims=True) + EPS)
    return (y * g.astype(jnp.float32)).astype(x.dtype)


def split_heads(x, h):
    b, l, _ = x.shape
    return x.reshape(b, l, h, -1).transpose(0, 2, 1, 3)


def merge_heads(x):
    b, h, l, d = x.shape
    return x.transpose(0, 2, 1, 3).reshape(b, l, h * d)


def axial_rope(x):
    l = x.shape[-2]
    t = jnp.arange(l)
    row = (t // GRID_W).astype(jnp.float32)
    col = (t % GRID_W).astype(jnp.float32)
    nf = MLA_ROPE // 4
    inv = ROPE_BASE ** (-jnp.arange(nf, dtype=jnp.float32) / nf)
    ang = jnp.concatenate([row[:, None] * inv, col[:, None] * inv], axis=-1)
    cos, sin = jnp.cos(ang), jnp.sin(ang)
    xf = x.astype(jnp.float32).reshape(x.shape[:-1] + (MLA_ROPE // 2, 2))
    x1, x2 = xf[..., 0], xf[..., 1]
    out = jnp.stack([x1 * cos - x2 * sin, x1 * sin + x2 * cos], axis=-1)
    return out.reshape(x.shape).astype(x.dtype)


def joint_attention(qs, ks, vs, scale):
    b, h, l, _ = qs[0].shape
    nb = l // Q_BLOCK
    splits = [int(s) for s in np.cumsum([k.shape[2] for k in ks])[:-1]]

    def block(i):
        start = i * Q_BLOCK
        s = jnp.concatenate(
            [jnp.einsum('bhqd,bhkd->bhqk', lax.dynamic_slice_in_dim(q, start, Q_BLOCK, axis=2), k)
             for q, k in zip(qs, ks)], axis=-1).astype(jnp.float32) * scale
        p = jax.nn.softmax(s, axis=-1)
        ps = jnp.split(p, splits, axis=-1)
        out = jnp.einsum('bhqk,bhkd->bhqd', ps[0].astype(vs[0].dtype), vs[0])
        for j in range(1, len(vs)):
            out = out + jnp.einsum('bhqk,bhkd->bhqd', ps[j].astype(vs[j].dtype), vs[j])
        return out

    outs = lax.map(block, jnp.arange(nb))
    return jnp.moveaxis(outs, 0, 2).reshape(b, h, l, -1)


def log_decay(p):
    return jnp.log1p(-jnp.exp2(p.astype(jnp.float32)))


def retention_chunkwise(q, k, v, lg, s0):
    dtype = v.dtype
    q, k, v = q.astype(jnp.float32), k.astype(jnp.float32), v.astype(jnp.float32)
    b, h, l, dk = q.shape
    dv = v.shape[-1]
    n = l // RET_CHUNK
    qc = q.reshape(b, h, n, RET_CHUNK, dk)
    kc = k.reshape(b, h, n, RET_CHUNK, dk)
    vc = v.reshape(b, h, n, RET_CHUNK, dv)
    pos = jnp.arange(RET_CHUNK, dtype=jnp.float32)
    lgc = lg[:, None]
    diff = pos[:, None] - pos[None, :]
    dmask = jnp.where(diff >= 0, jnp.exp(lgc[:, :, None] * jnp.maximum(diff, 0.0)), 0.0)
    s = jnp.einsum('bhncd,bhnmd->bhncm', qc, kc) * dmask[None, :, None]
    o_intra = jnp.einsum('bhncm,bhnme->bhnce', s, vc)
    k_dec = jnp.exp(lgc * (RET_CHUNK - 1 - pos))
    kv = jnp.einsum('bhnmd,bhnme->bhnde', kc * k_dec[None, :, None, :, None], vc)
    chunk_dec = jnp.exp(lg * RET_CHUNK)[:, None, None]

    def step(state, kv_i):
        return chunk_dec * state + kv_i, state

    s_fin, s_prev = lax.scan(step, s0.astype(jnp.float32), jnp.moveaxis(kv, 2, 0))
    q_dec = jnp.exp(lgc * (pos + 1.0))
    o_cross = jnp.einsum('bhncd,nbhde->bhnce', qc * q_dec[None, :, None, :, None], s_prev)
    return (o_intra + o_cross).reshape(b, h, l, dv).astype(dtype), s_fin.astype(dtype)


def retention_bidir(q, k, v, lg_f, lg_b, s_f, s_b):
    o_f, fin_f = retention_chunkwise(q, k, v, lg_f, s_f)
    o_b, fin_b = retention_chunkwise(jnp.flip(q, 2), jnp.flip(k, 2), jnp.flip(v, 2), lg_b, s_b)
    return o_f + jnp.flip(o_b, 2), fin_f, fin_b


def retention_out(o, g):
    of = o.astype(jnp.float32)
    mu = jnp.mean(of, axis=-1, keepdims=True)
    var = jnp.mean(jnp.square(of - mu), axis=-1, keepdims=True)
    on = ((of - mu) * lax.rsqrt(var + EPS)).astype(o.dtype)
    return merge_heads(on) * jax.nn.silu(g)


def even_project(h, w_in):
    sizes = [H_RET * RET_DK, H_RET * RET_DK, H_RET * RET_DV, H_RET * RET_DV,
             H_NA * HEAD_DIM, H_NA * HEAD_DIM, H_NA * HEAD_DIM]
    parts = jnp.split(h @ w_in, [int(s) for s in np.cumsum(sizes)[:-1]], axis=-1)
    rq, rk, rv, rg, nq, nk, nv = parts
    rq = split_heads(rq, H_RET)
    rk = split_heads(rk, H_RET) * (RET_DK ** -0.5)
    rv = split_heads(rv, H_RET)
    return rq, rk, rv, rg, split_heads(nq, H_NA), split_heads(nk, H_NA), split_heads(nv, H_NA)


def neighborhood_attention(q, k, v, k_ctx, v_ctx, rpb):
    b, h, l, d = q.shape
    rows = l // GRID_W
    wr = min(WIN_R, rows)
    r = np.arange(rows)
    row_idx = np.clip(r - wr // 2, 0, rows - wr)[:, None] + np.arange(wr)[None]
    blk = np.arange(NA_NCB)
    col_start = np.clip(blk * NA_QB - WIN_C // 2, 0, GRID_W - NA_KBW)
    col_idx = col_start[:, None] + np.arange(NA_KBW)[None]
    q_col = blk[:, None] * NA_QB + np.arange(NA_QB)[None]
    win_start = np.clip(q_col - WIN_C // 2, 0, GRID_W - WIN_C)
    valid = (col_idx[:, None, :] >= win_start[:, :, None]) & (col_idx[:, None, :] < win_start[:, :, None] + WIN_C)
    dr = row_idx - r[:, None] + (WIN_R - 1)
    dc = np.clip(col_idx[:, None, :] - q_col[:, :, None], -(WIN_C - 1), WIN_C - 1) + (WIN_C - 1)
    bias = rpb[:, dr[:, None, None, :, None], dc[None, :, :, None, :]].astype(jnp.float32)
    bias = jnp.where(valid[None, None, :, :, None, :], bias, NEG_INF).reshape(h, rows, NA_NCB, NA_QB, wr * NA_KBW)
    qg = q.reshape(b, h, rows, NA_NCB, NA_QB, d)
    gidx = (row_idx[:, None, :, None], col_idx[None, :, None, :])
    kg = k.reshape(b, h, rows, GRID_W, d)[:, :, gidx[0], gidx[1]].reshape(b, h, rows, NA_NCB, wr * NA_KBW, d)
    vg = v.reshape(b, h, rows, GRID_W, d)[:, :, gidx[0], gidx[1]].reshape(b, h, rows, NA_NCB, wr * NA_KBW, d)
    scale = HEAD_DIM ** -0.5
    s_loc = jnp.einsum('bhrnqd,bhrnkd->bhrnqk', qg, kg).astype(jnp.float32) * scale + bias[None]
    s_ctx = jnp.einsum('bhrnqd,bhkd->bhrnqk', qg, k_ctx).astype(jnp.float32) * scale
    p = jax.nn.softmax(jnp.concatenate([s_loc, s_ctx], axis=-1), axis=-1).astype(v.dtype)
    nloc = wr * NA_KBW
    o = (jnp.einsum('bhrnqk,bhrnkd->bhrnqd', p[..., :nloc], vg)
         + jnp.einsum('bhrnqk,bhkd->bhrnqd', p[..., nloc:], v_ctx))
    return o.reshape(b, h, l, d)


def mixer_ac_context(h, w_in, w_out, lg_f, lg_b):
    rq, rk, rv, rg, nq, nk, nv = even_project(h, w_in)
    zeros = jnp.zeros((h.shape[0], H_RET, RET_DK, RET_DV), h.dtype)
    o_ret, s_f, s_b = retention_bidir(rq, rk, rv, lg_f, lg_b, zeros, zeros)
    o_na = joint_attention([nq], [nk], [nv], HEAD_DIM ** -0.5)
    y = jnp.concatenate([retention_out(o_ret, rg), merge_heads(o_na)], axis=-1) @ w_out
    return y, s_f, s_b, nk, nv


def mixer_ac_latent(h, w_in, w_out, lg_f, lg_b, s_f, s_b, k_ctx, v_ctx, rpb):
    rq, rk, rv, rg, nq, nk, nv = even_project(h, w_in)
    o_ret, _, _ = retention_bidir(rq, rk, rv, lg_f, lg_b, s_f, s_b)
    o_na = neighborhood_attention(nq, nk, nv, k_ctx, v_ctx, rpb)
    return jnp.concatenate([retention_out(o_ret, rg), merge_heads(o_na)], axis=-1) @ w_out


def mla_project(h, w_in, q_norm, kv_norm, w_uq):
    c_q, c_kv, k_pe = jnp.split(h @ w_in, [MLA_Q_LORA, MLA_Q_LORA + MLA_KV_LORA], axis=-1)
    c_kv = rms_norm(c_kv, kv_norm)
    q = split_heads(rms_norm(c_q, q_norm) @ w_uq, MLA_HEADS)
    return q[..., :MLA_NOPE], q[..., MLA_NOPE:], c_kv, k_pe


def bcast_heads(k_pe):
    b, l, r = k_pe.shape
    return jnp.broadcast_to(k_pe[:, None], (b, MLA_HEADS, l, r))


def mla_context(h, w_in, q_norm, kv_norm, w_uq, w_uk, w_uv, w_out):
    q_nope, q_pe, c_kv, k_pe = mla_project(h, w_in, q_norm, kv_norm, w_uq)
    k_nope = split_heads(c_kv @ w_uk, MLA_HEADS)
    v = split_heads(c_kv @ w_uv, MLA_HEADS)
    q = jnp.concatenate([q_nope, q_pe], axis=-1)
    k = jnp.concatenate([k_nope, bcast_heads(k_pe)], axis=-1)
    o = joint_attention([q], [k], [v], MLA_SCALE)
    return merge_heads(o) @ w_out, c_kv, k_pe


def mla_latent(h, w_in, q_norm, kv_norm, w_uq, w_uk, w_uv, w_out, ckv_ctx, kpe_ctx):
    q_nope, q_pe, c_kv, k_pe = mla_project(h, w_in, q_norm, kv_norm, w_uq)
    k_nope = split_heads(c_kv @ w_uk, MLA_HEADS)
    v = split_heads(c_kv @ w_uv, MLA_HEADS)
    kc_nope = split_heads(ckv_ctx @ w_uk, MLA_HEADS)
    vc = split_heads(ckv_ctx @ w_uv, MLA_HEADS)
    q_lat = jnp.concatenate([q_nope, axial_rope(q_pe)], axis=-1)
    k_lat = jnp.concatenate([k_nope, bcast_heads(axial_rope(k_pe))], axis=-1)
    q_ctx = jnp.concatenate([q_nope, q_pe], axis=-1)
    k_ctx = jnp.concatenate([kc_nope, bcast_heads(kpe_ctx)], axis=-1)
    o = joint_attention([q_lat, q_ctx], [k_lat, k_ctx], [v, vc], MLA_SCALE)
    return merge_heads(o) @ w_out


def modulation(cond, w_ada, b_ada):
    m = jax.nn.silu(cond) @ w_ada + b_ada
    return m.reshape(cond.shape[0], 6, D_MODEL)


def modulate(x, g, shift, scale):
    return rms_norm(x, g) * (1 + scale[:, None, :]) + shift[:, None, :]


def gated_residual(x, y, g, gate):
    return x + gate[:, None, :] * rms_norm(y, g)


def channel_mixer(h, w1, w2):
    return jnp.square(jax.nn.relu(h @ w1)) @ w2


def setup_inputs(seed: int = 0) -> dict:
    key = jax.random.key(seed)
    ks = iter(jax.random.split(key, 40))
    f32 = jnp.float32

    def nrm(shape, scale=1.0):
        return jax.random.normal(next(ks), shape, f32) * scale

    base_decay = -5.0 - jnp.arange(H_RET, dtype=f32)
    return {
        'x_prompt': nrm((BATCH, SEQ, D_MODEL)),
        'x_sample': nrm((DEC_BATCH, DEC_SEQ, D_MODEL)),
        'state_ret_fwd': nrm((DEC_BATCH, N_A_LAYERS, H_RET, RET_DK, RET_DV), 0.5),
        'state_ret_bwd': nrm((DEC_BATCH, N_A_LAYERS, H_RET, RET_DK, RET_DV), 0.5),
        'cache_na_k': nrm((DEC_BATCH, N_A_LAYERS, H_NA, PAST_LEN, HEAD_DIM)),
        'cache_na_v': nrm((DEC_BATCH, N_A_LAYERS, H_NA, PAST_LEN, HEAD_DIM)),
        'cache_mla_ckv': nrm((DEC_BATCH, N_C_LAYERS, PAST_LEN, MLA_KV_LORA)),
        'cache_mla_kpe': nrm((DEC_BATCH, N_C_LAYERS, PAST_LEN, MLA_ROPE)),
        'c': nrm((DEC_BATCH, D_MODEL)),
        'c_ctx': nrm((D_MODEL,)),
        'w_ada': nrm((DEPTH, D_MODEL, 6 * D_MODEL), 0.5 * D_MODEL ** -0.5),
        'b_ada': nrm((DEPTH, 6 * D_MODEL), 0.1),
        'norm_gains': 1.0 + nrm((DEPTH, 4, D_MODEL), 0.05),
        'w_mlp_in': nrm((DEPTH, D_MODEL, D_FF), D_MODEL ** -0.5),
        'w_mlp_out': nrm((DEPTH, D_FF, D_MODEL), D_FF ** -0.5),
        'w_in_ac': nrm((N_A_LAYERS, D_MODEL, AC_IN), D_MODEL ** -0.5),
        'w_out_ac': nrm((N_A_LAYERS, AC_OUT, D_MODEL), AC_OUT ** -0.5),
        'ret_decay_fwd': base_decay + nrm((N_A_LAYERS, H_RET), 0.1),
        'ret_decay_bwd': base_decay + nrm((N_A_LAYERS, H_RET), 0.1),
        'na_rpb': nrm((N_A_LAYERS, H_NA, 2 * WIN_R - 1, 2 * WIN_C - 1), 0.1),
        'w_in_c': nrm((N_C_LAYERS, D_MODEL, C_IN), D_MODEL ** -0.5),
        'mla_q_norm': 1.0 + nrm((N_C_LAYERS, MLA_Q_LORA), 0.05),
        'mla_kv_norm': 1.0 + nrm((N_C_LAYERS, MLA_KV_LORA), 0.05),
        'w_uq': nrm((N_C_LAYERS, MLA_Q_LORA, MLA_HEADS * (MLA_NOPE + MLA_ROPE)), MLA_Q_LORA ** -0.5),
        'w_uk': nrm((N_C_LAYERS, MLA_KV_LORA, MLA_HEADS * MLA_NOPE), MLA_KV_LORA ** -0.5),
        'w_uv': nrm((N_C_LAYERS, MLA_KV_LORA, MLA_HEADS * MLA_V), MLA_KV_LORA ** -0.5),
        'w_out_c': nrm((N_C_LAYERS, MLA_HEADS * MLA_V, D_MODEL), (MLA_HEADS * MLA_V) ** -0.5),
    }


def reference(x_prompt, x_sample, state_ret_fwd, state_ret_bwd, cache_na_k, cache_na_v,
              cache_mla_ckv, cache_mla_kpe, c, c_ctx, w_ada, b_ada, norm_gains, w_mlp_in, w_mlp_out,
              w_in_ac, w_out_ac, ret_decay_fwd, ret_decay_bwd, na_rpb, w_in_c, mla_q_norm,
              mla_kv_norm, w_uq, w_uk, w_uv, w_out_c):
    xp, xs = x_prompt, x_sample
    ret_f, ret_b, na_k, na_v, mla_ckv, mla_kpe = [], [], [], [], [], []
    for layer in range(DEPTH):
        mc = modulation(c_ctx[None], w_ada[layer], b_ada[layer])
        ml = modulation(c, w_ada[layer], b_ada[layer])
        g = norm_gains[layer]
        hp = modulate(xp, g[0], mc[:, 0], mc[:, 1])
        hs = modulate(xs, g[0], ml[:, 0], ml[:, 1])
        if layer % 2 == 0:
            ia = layer // 2
            lg_f = log_decay(ret_decay_fwd[ia])
            lg_b = log_decay(ret_decay_bwd[ia])
            yp, s_f, s_b, nk, nv = mixer_ac_context(hp, w_in_ac[ia], w_out_ac[ia], lg_f, lg_b)
            ret_f.append(s_f)
            ret_b.append(s_b)
            na_k.append(nk)
            na_v.append(nv)
            ys = mixer_ac_latent(hs, w_in_ac[ia], w_out_ac[ia], lg_f, lg_b,
                                 state_ret_fwd[:, ia], state_ret_bwd[:, ia],
                                 cache_na_k[:, ia], cache_na_v[:, ia], na_rpb[ia])
        else:
            ic = layer // 2
            yp, ckv, kpe = mla_context(hp, w_in_c[ic], mla_q_norm[ic], mla_kv_norm[ic],
                                       w_uq[ic], w_uk[ic], w_uv[ic], w_out_c[ic])
            mla_ckv.append(ckv)
            mla_kpe.append(kpe)
            ys = mla_latent(hs, w_in_c[ic], mla_q_norm[ic], mla_kv_norm[ic], w_uq[ic], w_uk[ic],
                            w_uv[ic], w_out_c[ic], cache_mla_ckv[:, ic], cache_mla_kpe[:, ic])
        xp = gated_residual(xp, yp, g[1], mc[:, 2])
        xs = gated_residual(xs, ys, g[1], ml[:, 2])
        hp = modulate(xp, g[2], mc[:, 3], mc[:, 4])
        hs = modulate(xs, g[2], ml[:, 3], ml[:, 4])
        xp = gated_residual(xp, channel_mixer(hp, w_mlp_in[layer], w_mlp_out[layer]), g[3], mc[:, 5])
        xs = gated_residual(xs, channel_mixer(hs, w_mlp_in[layer], w_mlp_out[layer]), g[3], ml[:, 5])
    new_ret_fwd = jnp.stack(ret_f, axis=1)
    new_ret_bwd = jnp.stack(ret_b, axis=1)
    new_na_k = jnp.stack(na_k, axis=1)
    new_na_v = jnp.stack(na_v, axis=1)
    new_mla_ckv = jnp.stack(mla_ckv, axis=1)
    new_mla_kpe = jnp.stack(mla_kpe, axis=1)
    return (xp, xs, new_ret_fwd, new_ret_bwd, new_na_k, new_na_v, new_mla_ckv, new_mla_kpe)
```

```cpp
#include <hip/hip_runtime.h>
#include <hip/hip_cooperative_groups.h>
#include <cstdio>
namespace cg = cooperative_groups;

#define DI __device__ __forceinline__
#define LAS __attribute__((address_space(3)))
typedef unsigned short bf16;
typedef short bf16x8 __attribute__((ext_vector_type(8)));
typedef short s16x4 __attribute__((ext_vector_type(4)));
typedef float f32x4 __attribute__((ext_vector_type(4)));
typedef float f32x2 __attribute__((ext_vector_type(2)));
typedef float f32x16 __attribute__((ext_vector_type(16)));
typedef unsigned u32x4 __attribute__((ext_vector_type(4)));
typedef unsigned u32x2 __attribute__((ext_vector_type(2)));
typedef __bf16 bf16x2_t __attribute__((ext_vector_type(2)));
typedef LAS unsigned char* lptr;

#define LDS_WAIT() asm volatile("s_waitcnt lgkmcnt(0)" ::: "memory")
#define MFMA32(a, b, c) __builtin_amdgcn_mfma_f32_32x32x16_bf16((a), (b), (c), 0, 0, 0)

DI unsigned pk2(float lo, float hi) { f32x2 v = {lo, hi}; bf16x2_t b = __builtin_convertvector(v, bf16x2_t); return __builtin_bit_cast(unsigned, b); }
DI bf16 f2bf(float f) { return (bf16)(pk2(f, 0.f) & 0xffffu); }
DI float bf2f(unsigned b) { return __builtin_bit_cast(float, (b & 0xffffu) << 16); }
DI float bflo(unsigned w) { return __builtin_bit_cast(float, w << 16); }
DI float bfhi(unsigned w) { return __builtin_bit_cast(float, w & 0xffff0000u); }
DI float wave_sum(float v) {
#pragma unroll
  for (int o = 1; o < 64; o <<= 1) v += __shfl_xor(v, o);
  return v;
}
DI int crow(int reg, int h) { return (reg & 3) + 8 * (reg >> 2) + 4 * h; }
DI f32x16 zero16() { f32x16 z; for (int i = 0; i < 16; ++i) z[i] = 0.f; return z; }

constexpr int D = 1024, NP = 8192, NS = 16384, NT = 24576, FF = 4096, ACIN = 3584, CINP = 768, NCTX = 2048;
constexpr float EPS = 1e-6f, LOG2E = 1.4426950408889634f;
constexpr size_t O_RF = 25165824, O_RB = 27262976, O_NK = 29360128, O_NV = 37748736, O_CKV = 46137344, O_KPE = 50331648;
constexpr size_t MiB = 1u << 20;
constexpr size_t WS_MOD = 1 * MiB, WS_ROPE = 2 * MiB, WS_KPE = 3 * MiB, WS_NACTX = 5 * MiB;
constexpr size_t WS_W1T = 13 * MiB, WS_W2T = 21 * MiB, WS_WA = 29 * MiB;
constexpr size_t WS_H = 40 * MiB, WS_Y = 88 * MiB, WS_BIG = 184 * MiB, WS_END = 376 * MiB;
constexpr size_t WA_OUT_E = 7 * MiB, WA_UQ = 1536 * 1024, WA_UKV = 3 * MiB, WA_OUT_O = 4 * MiB;
constexpr size_t H_CKVN = 20 * MiB;
constexpr size_t Y_KVB = 24 * MiB;
constexpr size_t BIG_KV = 72 * MiB;
constexpr int LDS_BYTES = 147456;

struct Args { const float* in[27]; float* out; unsigned char* ws; };

namespace pg8 {
constexpr int BM = 256, BK = 64, HALF = 128, HTB = HALF * BK * 2, NXCD = 8, WGM = 8;
DI int lds_byte(int r, int c) { const int st = (r >> 4) * 2 + (c >> 5), rr = r & 15, cc = c & 31, ob = rr * 64 + cc * 2; return st * 1024 + (ob ^ (((ob >> 9) & 1) << 5)); }
DI void stage_rc(int b, int& R, int& C) { const int st = b / 1024, sb = b % 1024, swz = sb ^ (((sb >> 9) & 1) << 5); R = (st >> 1) * 16 + swz / 64; C = (st & 1) * 32 + (swz % 64) / 2; }
DI int perm32(int rho) { const int n = rho >> 4, i = rho & 15; return 8 * (i >> 2) + 4 * n + (i & 3); }
struct Unit { int pm, pn; };
struct Gemm { const bf16* A; const bf16* Bt; int M, N, K; };
struct StaticOrder {
  int nM, nN, nwg, G, c;
  DI void init(int M, int N, int G_, int c_) { nM = M / BM; nN = N / BM; nwg = nM * nN; G = G_; c = c_; }
  DI bool next(int i, Unit& u) const {
    const long L = (long)i * G + c; if (L >= nwg) return false;
    int wgid = (int)L; { const int q = nwg / NXCD, r = nwg % NXCD, xcd = wgid % NXCD, off = wgid / NXCD; wgid = (xcd < r ? xcd * (q + 1) : r * (q + 1) + (xcd - r) * q) + off; }
    const int nig = WGM * nN, gid = wgid / nig, fm = gid * WGM, gsz = (nM - fm) < WGM ? (nM - fm) : WGM;
    u.pm = fm + ((wgid % nig) % gsz); u.pn = (wgid % nig) / gsz; return true;
  }
};
struct EpiF32 {
  static constexpr bool PERM = false;
  float* C; int ldc;
  DI void operator()(const f32x4 (&acc)[2][2][4][2], const Unit& u, int wr, int wc, int fr, int fq) const {
    const int row0 = u.pm * BM + wr * 64 + fr, col0 = u.pn * BM + wc * 32 + 4 * fq;
#pragma unroll
    for (int ai = 0; ai < 2; ++ai)
#pragma unroll
      for (int m = 0; m < 4; ++m) { float* rowp = C + (size_t)(row0 + ai * HALF + m * 16) * ldc + col0;
#pragma unroll
        for (int bj = 0; bj < 2; ++bj)
#pragma unroll
          for (int n = 0; n < 2; ++n) *(f32x4*)(rowp + bj * HALF + n * 16) = acc[ai][bj][m][n]; }
  }
};
template <int MODE> struct EpiBf16 {
  static constexpr bool PERM = true;
  bf16* O; int ldc; float* nk_out; float* nv_out;
  DI void operator()(const f32x4 (&acc)[2][2][4][2], const Unit& u, int wr, int wc, int fr, int fq) const {
    const int row0 = u.pm * BM + wr * 64 + fr; const int col0 = u.pn * BM + wc * 32 + 8 * fq;
    const float sc = (MODE == 2 && (u.pn == 2 || u.pn == 3)) ? 0.125f : 1.0f;
    const bool side = (MODE == 2) && (u.pn >= 10) && (u.pm < 32);
    float* sbase = (u.pn >= 12) ? nv_out : nk_out;
    const int scol0 = col0 - ((u.pn >= 12) ? 3072 : 2560);
#pragma unroll
    for (int ai = 0; ai < 2; ++ai)
#pragma unroll
      for (int m = 0; m < 4; ++m) { const int row = row0 + ai * HALF + m * 16; bf16* rowp = O + (size_t)row * ldc + col0;
#pragma unroll
        for (int bj = 0; bj < 2; ++bj) { f32x4 v0 = acc[ai][bj][m][0], v1 = acc[ai][bj][m][1];
          if (MODE == 1) {
#pragma unroll
            for (int j = 0; j < 4; ++j) { float a = fmaxf(v0[j], 0.f), b = fmaxf(v1[j], 0.f); v0[j] = a * a; v1[j] = b * b; } }
          if (MODE == 2) { v0 = v0 * sc; v1 = v1 * sc; }
          u32x4 w; w.x = pk2(v0[0], v0[1]); w.y = pk2(v0[2], v0[3]); w.z = pk2(v1[0], v1[1]); w.w = pk2(v1[2], v1[3]);
          *(u32x4*)(rowp + bj * HALF) = w;
          if (MODE == 2) { if (side) { const int cc = scol0 + bj * HALF; const int hh = cc >> 6, dd = cc & 63; const int b = row >> 8, s = row & 255;
              float* dst = sbase + ((size_t)((b * 2) * 8 + hh) * 256 + s) * 64 + dd;
              *(f32x4*)dst = v0; *(f32x4*)(dst + 4) = v1; } }
        } }
  }
};

template <class Epi>
DI void gemm_phase(lptr lds, const Gemm g, const StaticOrder& S, const Epi& E, const int tid) {
  const int wid = __builtin_amdgcn_readfirstlane(tid >> 6), lane = tid & 63, wr = wid >> 2, wc = wid & 3, fr = lane & 15, fq = lane >> 4;
  const int K = g.K, nt = K / BK;
  unsigned voffA[2], voffB[2];
#pragma unroll
  for (int i = 0; i < 2; ++i) { int R, C; stage_rc(tid * 16 + i * 8192, R, C); const int Rb = Epi::PERM ? ((R & ~31) + perm32(R & 31)) : R;
    voffA[i] = (unsigned)(R * K + C) * 2u; voffB[i] = (unsigned)(Rb * K + C) * 2u; }
  const size_t kstep = (size_t)(BK * 2);
  const size_t hstep = (size_t)HALF * K * 2;
  const size_t tstep = 2 * hstep;
  const unsigned ldsw = (unsigned)wid * 1024u;
  const int aoff = lds_byte(wr * 64 + fr, fq * 8), boff = lds_byte(wc * 32 + fr, fq * 8);
#define PG8_SA(b, h) (((b) * 2 + (h)) * HTB)
#define PG8_SB(b, h) ((4 + (b) * 2 + (h)) * HTB)
#define PG8_STAGE(bufoff, gbase, voff) do { _Pragma("unroll") for (int _i = 0; _i < 2; ++_i) \
    __builtin_amdgcn_global_load_lds((const unsigned*)((const char*)(gbase) + (voff)[_i]), (LAS unsigned*)(lds + (bufoff) + ldsw + _i * 8192), 16, 0, 0); } while (0)
#define PG8_LDA(dst, b, h) do { _Pragma("unroll") for (int m = 0; m < 4; ++m) _Pragma("unroll") for (int k = 0; k < 2; ++k) dst[m][k] = *(const LAS bf16x8*)(lds + PG8_SA(b, h) + aoff + m * 2048 + k * 1024); } while (0)
#define PG8_LDB(dst, b, h) do { _Pragma("unroll") for (int n = 0; n < 2; ++n) _Pragma("unroll") for (int k = 0; k < 2; ++k) dst[n][k] = *(const LAS bf16x8*)(lds + PG8_SB(b, h) + boff + n * 2048 + k * 1024); } while (0)
#define PG8_MMA(ai, bj, At, Bt) do { __builtin_amdgcn_s_setprio(1); _Pragma("unroll") for (int m = 0; m < 4; ++m) _Pragma("unroll") for (int n = 0; n < 2; ++n) _Pragma("unroll") for (int k = 0; k < 2; ++k) \
    acc[ai][bj][m][n] = __builtin_amdgcn_mfma_f32_16x16x32_bf16(Bt[n][k], At[m][k], acc[ai][bj][m][n], 0, 0, 0); __builtin_amdgcn_s_setprio(0); } while (0)
#define PG8_WAIT_V(n) asm volatile("s_waitcnt vmcnt(" #n ")" ::: "memory")
#define PG8_WAIT_L(n) asm volatile("s_waitcnt lgkmcnt(" #n ")" ::: "memory")
#define PG8_BAR __builtin_amdgcn_s_barrier()
#define PG8_SCHED __builtin_amdgcn_sched_barrier(0)
  Unit cur, nxt; int ui = 0;
  if (!S.next(0, cur)) return;
  f32x4 acc[2][2][4][2];
#pragma unroll
  for (int a = 0; a < 2; ++a)
#pragma unroll
    for (int b = 0; b < 2; ++b)
#pragma unroll
      for (int m = 0; m < 4; ++m)
#pragma unroll
        for (int n = 0; n < 2; ++n) acc[a][b][m][n] = (f32x4){0.f, 0.f, 0.f, 0.f};
  bf16x8 At[4][2], B0[2][2], B1[2][2];
  const char* cA = (const char*)g.A + (size_t)cur.pm * tstep; const char* cB = (const char*)g.Bt + (size_t)cur.pn * tstep;
  PG8_STAGE(PG8_SB(0, 0), cB, voffB); PG8_STAGE(PG8_SA(0, 0), cA, voffA); PG8_STAGE(PG8_SB(0, 1), cB + hstep, voffB); PG8_STAGE(PG8_SA(0, 1), cA + hstep, voffA);
  if (wr == 1) PG8_BAR;
  PG8_WAIT_V(4); PG8_BAR;
  PG8_STAGE(PG8_SB(1, 0), cB + kstep, voffB); PG8_STAGE(PG8_SA(1, 0), cA + kstep, voffA); PG8_STAGE(PG8_SB(1, 1), cB + hstep + kstep, voffB);
  PG8_WAIT_V(6); PG8_BAR;
  for (;;) {
    const bool has_next = S.next(ui + 1, nxt);
    const char* nA = has_next ? (const char*)g.A + (size_t)nxt.pm * tstep : cA; const char* nB = has_next ? (const char*)g.Bt + (size_t)nxt.pn * tstep : cB;
    for (int t = 0; t < nt; t += 2) {
      const bool last = (t == nt - 2);
      const char* a1 = cA + (size_t)(t + 1) * kstep;
      const char* a2 = last ? nA : cA + (size_t)(t + 2) * kstep; const char* b2 = last ? nB : cB + (size_t)(t + 2) * kstep;
      const char* a3 = a2 + kstep; const char* b3 = b2 + kstep;
      PG8_LDB(B0, 0, 0); PG8_SCHED; PG8_LDA(At, 0, 0); PG8_STAGE(PG8_SA(1, 1), a1 + hstep, voffA);
      PG8_WAIT_L(8); PG8_BAR; PG8_WAIT_L(0); PG8_MMA(0, 0, At, B0); PG8_BAR; PG8_SCHED;
      PG8_LDB(B1, 0, 1); PG8_STAGE(PG8_SB(0, 0), b2, voffB);
      PG8_BAR; PG8_WAIT_L(0); PG8_MMA(0, 1, At, B1); PG8_BAR;
      PG8_LDA(At, 0, 1); PG8_STAGE(PG8_SA(0, 0), a2, voffA);
      PG8_BAR; PG8_WAIT_L(0); PG8_MMA(1, 0, At, B0); PG8_BAR; PG8_SCHED;
      PG8_STAGE(PG8_SB(0, 1), b2 + hstep, voffB);
      PG8_WAIT_V(6); PG8_BAR; PG8_MMA(1, 1, At, B1); PG8_BAR;
      PG8_LDB(B0, 1, 0); PG8_SCHED; PG8_LDA(At, 1, 0); PG8_STAGE(PG8_SA(0, 1), a2 + hstep, voffA);
      PG8_WAIT_L(8); PG8_BAR; PG8_WAIT_L(0); PG8_MMA(0, 0, At, B0); PG8_BAR; PG8_SCHED;
      PG8_LDB(B1, 1, 1); PG8_STAGE(PG8_SB(1, 0), b3, voffB);
      PG8_BAR; PG8_WAIT_L(0); PG8_MMA(0, 1, At, B1); PG8_BAR;
      PG8_LDA(At, 1, 1); PG8_STAGE(PG8_SA(1, 0), a3, voffA);
      PG8_BAR; PG8_WAIT_L(0); PG8_MMA(1, 0, At, B0); PG8_BAR; PG8_SCHED;
      PG8_STAGE(PG8_SB(1, 1), b3 + hstep, voffB);
      PG8_WAIT_V(6); PG8_BAR; PG8_MMA(1, 1, At, B1); PG8_BAR;
    }
    E(acc, cur, wr, wc, fr, fq);
    if (!has_next) break;
#pragma unroll
    for (int a = 0; a < 2; ++a)
#pragma unroll
      for (int b = 0; b < 2; ++b)
#pragma unroll
        for (int m = 0; m < 4; ++m)
#pragma unroll
          for (int n = 0; n < 2; ++n) acc[a][b][m][n] = (f32x4){0.f, 0.f, 0.f, 0.f};
    cur = nxt; cA = nA; cB = nB; ++ui;
  }
  PG8_WAIT_V(0);
  if (wr == 0) PG8_BAR;
  PG8_BAR;
#undef PG8_SA
#undef PG8_SB
#undef PG8_STAGE
#undef PG8_LDA
#undef PG8_LDB
#undef PG8_MMA
#undef PG8_WAIT_V
#undef PG8_WAIT_L
#undef PG8_BAR
#undef PG8_SCHED
}
}

struct Ctx {
  const float* const* in; float* out; unsigned char* ws; lptr lds;
  int tid, lane, wave, G, bid;
};
DI float log_decay2(float p) { return log1pf(-exp2f(p)) * LOG2E; }

DI void transpose_item(const float* W, int K, int N, bf16* WT, int row_off, LAS float* scr, int item, int lane) {
  const int nblk = N / 32, kb = item / nblk, nb = item % nblk, k0 = 64 * kb, n0 = 32 * nb;
#pragma unroll 8
  for (int i = 0; i < 32; ++i) { const int kk = 2 * i + (lane >> 5); scr[kk * 33 + (lane & 31)] = W[(size_t)(k0 + kk) * N + n0 + (lane & 31)]; }
  LDS_WAIT(); asm volatile("" ::: "memory");
  const int c = lane & 7;
#pragma unroll
  for (int j = 0; j < 4; ++j) { const int n = (lane >> 3) + 8 * j; const LAS float* s = scr + (8 * c) * 33 + n;
    u32x4 o; o.x = pk2(s[0 * 33], s[1 * 33]); o.y = pk2(s[2 * 33], s[3 * 33]); o.z = pk2(s[4 * 33], s[5 * 33]); o.w = pk2(s[6 * 33], s[7 * 33]);
    *(u32x4*)(WT + (size_t)(row_off + n0 + n) * K + k0 + 8 * c) = o; }
  LDS_WAIT(); asm volatile("" ::: "memory");
}
DI void convert_weights(const Ctx& c, int l) {
  LAS float* scr = (LAS float*)(c.lds + c.wave * 16384);
  const int gw = c.bid * 8 + c.wave, NGW = c.G * 8;
  bf16* W1T = (bf16*)(c.ws + WS_W1T); bf16* W2T = (bf16*)(c.ws + WS_W2T); unsigned char* WA = c.ws + WS_WA;
  const int hl = l >> 1;
  const float* w1 = c.in[13] + (size_t)l * D * FF; const float* w2 = c.in[14] + (size_t)l * FF * D;
  constexpr int I1 = 16 * 128, I2 = 64 * 32;
  if ((l & 1) == 0) {
    const float* win = c.in[15] + (size_t)hl * D * ACIN; const float* wout = c.in[16] + (size_t)hl * D * D;
    constexpr int IA = 16 * 112, IB = 16 * 32;
    for (int it = gw; it < I1 + I2 + IA + IB; it += NGW) {
      int r = it;
      if (r < I1) { transpose_item(w1, D, FF, W1T, 0, scr, r, c.lane); continue; } r -= I1;
      if (r < I2) { transpose_item(w2, FF, D, W2T, 0, scr, r, c.lane); continue; } r -= I2;
      if (r < IA) { transpose_item(win, D, ACIN, (bf16*)WA, 0, scr, r, c.lane); continue; } r -= IA;
      transpose_item(wout, D, D, (bf16*)(WA + WA_OUT_E), 0, scr, r, c.lane);
    }
  } else {
    const float* winc = c.in[20] + (size_t)hl * D * 672; const float* wuq = c.in[23] + (size_t)hl * 384 * 1536;
    const float* wuk = c.in[24] + (size_t)hl * 256 * 1024; const float* wuv = c.in[25] + (size_t)hl * 256 * 1024; const float* woc = c.in[26] + (size_t)hl * D * D;
    constexpr int IA = 16 * 21, IB = 6 * 48, IC = 4 * 32, ID = 16 * 32;
    for (int it = gw; it < I1 + I2 + IA + IB + 2 * IC + ID; it += NGW) {
      int r = it;
      if (r < I1) { transpose_item(w1, D, FF, W1T, 0, scr, r, c.lane); continue; } r -= I1;
      if (r < I2) { transpose_item(w2, FF, D, W2T, 0, scr, r, c.lane); continue; } r -= I2;
      if (r < IA) { transpose_item(winc, D, 672, (bf16*)WA, 0, scr, r, c.lane); continue; } r -= IA;
      if (r < IB) { transpose_item(wuq, 384, 1536, (bf16*)(WA + WA_UQ), 0, scr, r, c.lane); continue; } r -= IB;
      if (r < IC) { transpose_item(wuk, 256, 1024, (bf16*)(WA + WA_UKV), 0, scr, r, c.lane); continue; } r -= IC;
      if (r < IC) { transpose_item(wuv, 256, 1024, (bf16*)(WA + WA_UKV), 1024, scr, r, c.lane); continue; } r -= IC;
      transpose_item(woc, D, D, (bf16*)(WA + WA_OUT_O), 0, scr, r, c.lane);
    }
    u32x4* z = (u32x4*)(WA + (size_t)672 * D * 2);
    for (int i = c.bid * 512 + c.tid; i < 96 * D * 2 / 16; i += c.G * 512) z[i] = (u32x4){0u, 0u, 0u, 0u};
  }
}

DI void prologue(const Ctx& c) {
  float* MOD = (float*)(c.ws + WS_MOD);
  for (int item = c.bid; item < 4 * 48; item += c.G) {
    const int l = item / 48, n0 = (item % 48) * 128;
    LAS float* sil = (LAS float*)c.lds; LAS float* red = (LAS float*)(c.lds + 36864);
    for (int i = c.tid; i < 9 * 1024; i += 512) { const int r = i >> 10, k = i & 1023; const float x = (r == 0) ? c.in[9][k] : c.in[8][(r - 1) * 1024 + k]; sil[i] = x / (1.f + __expf(-x)); }
    __syncthreads();
    float acc[9][2];
#pragma unroll
    for (int r = 0; r < 9; ++r) { acc[r][0] = 0.f; acc[r][1] = 0.f; }
    const float* wp = c.in[10] + ((size_t)l * 1024 + c.wave * 128) * 6144 + n0 + 2 * c.lane;
#pragma unroll 4
    for (int k = 0; k < 128; ++k) { const f32x2 w = *(const f32x2*)(wp + (size_t)k * 6144);
#pragma unroll
      for (int r = 0; r < 9; ++r) { const float s = sil[r * 1024 + c.wave * 128 + k]; acc[r][0] += s * w.x; acc[r][1] += s * w.y; } }
#pragma unroll
    for (int r = 0; r < 9; ++r) { red[(c.wave * 9 + r) * 128 + 2 * c.lane] = acc[r][0]; red[(c.wave * 9 + r) * 128 + 2 * c.lane + 1] = acc[r][1]; }
    __syncthreads();
    for (int o = c.tid; o < 9 * 128; o += 512) { const int r = o >> 7, n = o & 127; float s = c.in[11][l * 6144 + n0 + n];
#pragma unroll
      for (int w = 0; w < 8; ++w) s += red[(w * 9 + r) * 128 + n];
      MOD[(size_t)(l * 9 + r) * 6144 + n0 + n] = s; }
    __syncthreads();
  }
  { float* RC = (float*)(c.ws + WS_ROPE); float* RS = RC + 32768;
    for (int i = c.bid * 512 + c.tid; i < 2048 * 16; i += c.G * 512) { const int t = i >> 4, j = i & 15; const float pos = (float)((j < 8) ? (t >> 6) : (t & 63));
      const float inv = exp2f(-(float)(j & 7) * 0.125f * 13.287712379549449f); const float a = pos * inv;
      const float k = rintf(a * 0.15915494309189535f); float r = fmaf(-k, 6.2831854820251465f, a); r = fmaf(k, 1.7484556e-07f, r);
      RC[i] = __cosf(r); RS[i] = __sinf(r); } }
  { bf16* NC = (bf16*)(c.ws + WS_NACTX);
    for (int i = c.bid * 512 + c.tid; i < 2 * 2 * 8 * 8 * 256 * 16; i += c.G * 512) {
      const int e4 = i & 15, key = (i >> 4) & 255, h = (i >> 12) & 7, b = (i >> 15) & 7, kv = (i >> 18) & 1, ia = (i >> 19) & 1;
      const f32x4 v = *(const f32x4*)(c.in[4 + kv] + ((((size_t)b * 2 + ia) * 8 + h) * 256 + key) * 64 + 4 * e4);
      u32x2 o; o.x = pk2(v[0], v[1]); o.y = pk2(v[2], v[3]); *(u32x2*)(NC + (size_t)i * 4) = o; } }
  convert_weights(c, 0);
}

DI void row_phase(const Ctx& c, int l, int kind) {
  const float* MOD = (const float*)(c.ws + WS_MOD); const float* NG = c.in[12];
  const float* Y = (const float*)(c.ws + WS_Y); bf16* Hb = (bf16*)(c.ws + WS_H);
  const int gw = c.bid * 8 + c.wave, NGW = c.G * 8;
  const int hl = (kind == 2) ? l + 1 : l;
  const bool want_h = hl < 4;
  const float* gy = NG + (size_t)(l * 4 + (kind == 1 ? 1 : 3)) * D;
  const float* gh = NG + (size_t)((want_h ? hl : 0) * 4 + (kind == 1 ? 2 : 0)) * D;
  for (int m = gw; m < NT; m += NGW) {
    const int r = (m < NP) ? 0 : 1 + ((m - NP) >> 11);
    f32x4 x[4];
    float* xo = c.out + (size_t)m * D;
    if (kind == 0) { const float* xi = (m < NP) ? c.in[0] + (size_t)m * D : c.in[1] + (size_t)(m - NP) * D;
#pragma unroll
      for (int j = 0; j < 4; ++j) x[j] = *(const f32x4*)(xi + 4 * (c.lane + 64 * j));
    } else {
      const float* gate = MOD + ((size_t)(l * 9 + r) * 6 + (kind == 1 ? 2 : 5)) * D;
      f32x4 y[4]; float ss = 0.f;
#pragma unroll
      for (int j = 0; j < 4; ++j) { y[j] = *(const f32x4*)(Y + (size_t)m * D + 4 * (c.lane + 64 * j)); x[j] = *(const f32x4*)(xo + 4 * (c.lane + 64 * j));
        ss += y[j][0] * y[j][0] + y[j][1] * y[j][1] + y[j][2] * y[j][2] + y[j][3] * y[j][3]; }
      const float rs = 1.0f / sqrtf(wave_sum(ss) * (1.f / D) + EPS);
#pragma unroll
      for (int j = 0; j < 4; ++j) { const f32x4 g = *(const f32x4*)(gy + 4 * (c.lane + 64 * j)); const f32x4 gt = *(const f32x4*)(gate + 4 * (c.lane + 64 * j));
        x[j] = x[j] + gt * (y[j] * rs * g); }
    }
#pragma unroll
    for (int j = 0; j < 4; ++j) *(f32x4*)(xo + 4 * (c.lane + 64 * j)) = x[j];
    if (want_h) {
      const float* shift = MOD + ((size_t)(hl * 9 + r) * 6 + (kind == 1 ? 3 : 0)) * D; const float* scale = shift + D;
      float ss = 0.f;
#pragma unroll
      for (int j = 0; j < 4; ++j) ss += x[j][0] * x[j][0] + x[j][1] * x[j][1] + x[j][2] * x[j][2] + x[j][3] * x[j][3];
      const float rs = 1.0f / sqrtf(wave_sum(ss) * (1.f / D) + EPS);
#pragma unroll
      for (int j = 0; j < 4; ++j) { const int o = 4 * (c.lane + 64 * j); const f32x4 g = *(const f32x4*)(gh + o); const f32x4 sh = *(const f32x4*)(shift + o); const f32x4 sc = *(const f32x4*)(scale + o);
        const f32x4 hv = (x[j] * rs * g) * (sc + 1.0f) + sh;
        u32x2 w; w.x = pk2(hv[0], hv[1]); w.y = pk2(hv[2], hv[3]); *(u32x2*)(Hb + (size_t)m * D + o) = w; }
    }
  }
}

DI void mla_rows(const Ctx& c, int ic) {
  const float* Cb = (const float*)(c.ws + WS_BIG); bf16* CQ = (bf16*)(c.ws + WS_H); bf16* CKV = (bf16*)(c.ws + WS_H + H_CKVN); bf16* KPE = (bf16*)(c.ws + WS_KPE);
  const float* RC = (const float*)(c.ws + WS_ROPE); const float* RS = RC + 32768;
  const float* qn = c.in[21] + ic * 384; const float* kvn = c.in[22] + ic * 256;
  const int gw = c.bid * 8 + c.wave, NGW = c.G * 8;
  for (int m = gw; m < NT + NCTX; m += NGW) {
    if (m < NT) {
      const float* cr = Cb + (size_t)m * CINP;
      float v[6]; float ss = 0.f;
#pragma unroll
      for (int j = 0; j < 6; ++j) { v[j] = cr[c.lane + 64 * j]; ss += v[j] * v[j]; }
      float rs = 1.0f / sqrtf(wave_sum(ss) * (1.f / 384.f) + EPS);
#pragma unroll
      for (int j = 0; j < 6; ++j) CQ[(size_t)m * 384 + c.lane + 64 * j] = f2bf(v[j] * rs * qn[c.lane + 64 * j]);
      const f32x4 kv = *(const f32x4*)(cr + 384 + 4 * c.lane);
      ss = kv[0] * kv[0] + kv[1] * kv[1] + kv[2] * kv[2] + kv[3] * kv[3];
      rs = 1.0f / sqrtf(wave_sum(ss) * (1.f / 256.f) + EPS);
      const f32x4 kn = kv * rs * *(const f32x4*)(kvn + 4 * c.lane);
      u32x2 w; w.x = pk2(kn[0], kn[1]); w.y = pk2(kn[2], kn[3]); *(u32x2*)(CKV + (size_t)m * 256 + 4 * c.lane) = w;
      const float xk = cr[640 + (c.lane & 31)]; const float pk = __shfl_xor(xk, 1);
      if (m < NP) { const int b = m >> 8, s = m & 255; const size_t slot = ((size_t)(b * 2 + ic) * 256 + s);
        *(f32x4*)(c.out + O_CKV + slot * 256 + 4 * c.lane) = kn;
        if (c.lane < 32) { c.out[O_KPE + slot * 32 + c.lane] = xk; KPE[(size_t)m * 32 + c.lane] = f2bf(xk); }
      } else { const int pos = (m - NP) & 2047; const int pi = (c.lane & 31) >> 1; const float cs = RC[pos * 16 + pi], sn = RS[pos * 16 + pi];
        const float val = (c.lane & 1) ? (pk * sn + xk * cs) : (xk * cs - pk * sn);
        if (c.lane < 32) KPE[(size_t)m * 32 + c.lane] = f2bf(val); }
    } else {
      const int cr = m - NT, b = cr >> 8, s = cr & 255; const size_t slot = ((size_t)(b * 2 + ic) * 256 + s);
      const f32x4 kv = *(const f32x4*)(c.in[6] + slot * 256 + 4 * c.lane);
      u32x2 w; w.x = pk2(kv[0], kv[1]); w.y = pk2(kv[2], kv[3]); *(u32x2*)(CKV + (size_t)m * 256 + 4 * c.lane) = w;
      if (c.lane < 32) KPE[(size_t)m * 32 + c.lane] = f2bf(c.in[7][slot * 32 + c.lane]);
    }
  }
}

DI void ret_kv_item(const Ctx& c, int item, int ia) {
  const int p = item >> 3, h = item & 7;
  const bf16* Pb = (const bf16*)(c.ws + WS_BIG);
  float* KVF = (float*)(c.ws + WS_Y); float* KVB = (float*)(c.ws + WS_Y + Y_KVB);
  const float lgf2 = log_decay2(c.in[17][ia * 8 + h]), lgb2 = log_decay2(c.in[18][ia * 8 + h]);
  LAS bf16* KtF = (LAS bf16*)c.lds; LAS bf16* KtB = (LAS bf16*)(c.lds + 33792); LAS bf16* Vt = (LAS bf16*)(c.lds + 67584);
#pragma unroll
  for (int it = 0; it < 4; ++it) { const int q = c.tid + 512 * it, tok = q >> 3, part = q & 7;
    const bf16* rowp = Pb + (size_t)(256 * p + tok) * ACIN + h * 64 + part * 8;
    const u32x4 kk = *(const u32x4*)(rowp + 512); const u32x4 vv = *(const u32x4*)(rowp + 1024);
    const int i = tok & 127; const float df = exp2f(lgf2 * (float)(127 - i)), db = exp2f(lgb2 * (float)i);
#pragma unroll
    for (int j = 0; j < 4; ++j) { const float k0 = bflo(kk[j]), k1 = bfhi(kk[j]); const int e0 = (part * 8 + 2 * j) * 264 + tok;
      KtF[e0] = f2bf(k0 * df); KtF[e0 + 264] = f2bf(k1 * df); KtB[e0] = f2bf(k0 * db); KtB[e0 + 264] = f2bf(k1 * db);
      Vt[e0] = (bf16)(vv[j] & 0xffffu); Vt[e0 + 264] = (bf16)(vv[j] >> 16); } }
  __syncthreads();
  { const int cw = c.wave >> 2, dir = (c.wave >> 1) & 1, eb = c.wave & 1, r = c.lane & 31, hh = c.lane >> 5;
    LAS bf16* Kt = dir ? KtB : KtF;
    f32x16 a0 = zero16(), a1 = zero16();
#pragma unroll
    for (int ks = 0; ks < 8; ++ks) { const int mo = cw * 128 + 16 * ks + 8 * hh;
      const bf16x8 A = *(const LAS bf16x8*)(Vt + (eb * 32 + r) * 264 + mo);
      const bf16x8 B0 = *(const LAS bf16x8*)(Kt + r * 264 + mo); const bf16x8 B1 = *(const LAS bf16x8*)(Kt + (32 + r) * 264 + mo);
      a0 = MFMA32(A, B0, a0); a1 = MFMA32(A, B1, a1); }
    float* dst = (dir ? KVB : KVF) + ((size_t)((2 * p + cw) * 8 + h) * 64) * 64;
#pragma unroll
    for (int reg = 0; reg < 16; ++reg) { const int e = eb * 32 + crow(reg, hh); dst[e * 64 + r] = a0[reg]; dst[e * 64 + 32 + r] = a1[reg]; } }
  __syncthreads();
}

DI void ret_out_item(const Ctx& c, int item, int ia) {
  const int p = item >> 3, h = item & 7;
  const bf16* Pb = (const bf16*)(c.ws + WS_BIG); bf16* AO = (bf16*)(c.ws + WS_H);
  const float* KVF = (const float*)(c.ws + WS_Y); const float* KVB = (const float*)(c.ws + WS_Y + Y_KVB);
  const float lgf2 = log_decay2(c.in[17][ia * 8 + h]), lgb2 = log_decay2(c.in[18][ia * 8 + h]);
  LAS bf16* Ks = (LAS bf16*)c.lds; LAS bf16* Vt = (LAS bf16*)(c.lds + 36864); LAS bf16* St = (LAS bf16*)(c.lds + 70656);
#pragma unroll
  for (int it = 0; it < 4; ++it) { const int q = c.tid + 512 * it, tok = q >> 3, part = q & 7;
    const bf16* rowp = Pb + (size_t)(256 * p + tok) * ACIN + h * 64 + part * 8;
    const u32x4 kk = *(const u32x4*)(rowp + 512); const u32x4 vv = *(const u32x4*)(rowp + 1024);
    *(LAS u32x4*)(Ks + tok * 72 + part * 8) = kk;
#pragma unroll
    for (int j = 0; j < 4; ++j) { const int e0 = (part * 8 + 2 * j) * 264 + tok; Vt[e0] = (bf16)(vv[j] & 0xffffu); Vt[e0 + 264] = (bf16)(vv[j] >> 16); } }
  { const bool lat = p >= 32; const int b = lat ? ((p - 32) >> 3) : p; const int n0 = lat ? 2 * ((p - 32) & 7) : 0; const int N = lat ? 16 : 2; const int cbase = lat ? 64 + b * 16 : 2 * p;
    const int e = c.tid >> 3, d0 = (c.tid & 7) * 8;
    const float Gf = exp2f(lgf2 * 128.f), Gb = exp2f(lgb2 * 128.f);
    const size_t eo = (size_t)e * 64 + d0;
    float sf[8], sb[8];
    if (lat) { const float* s0f = c.in[2] + ((size_t)((b * 2 + ia) * 8 + h) * 64) * 64; const float* s0b = c.in[3] + ((size_t)((b * 2 + ia) * 8 + h) * 64) * 64;
#pragma unroll
      for (int j = 0; j < 8; ++j) { sf[j] = s0f[(d0 + j) * 64 + e]; sb[j] = s0b[(d0 + j) * 64 + e]; }
    } else {
#pragma unroll
      for (int j = 0; j < 8; ++j) { sf[j] = 0.f; sb[j] = 0.f; } }
    for (int j = 0; j < n0; ++j) { const float* kv = KVF + ((size_t)((cbase + j) * 8 + h) * 4096) + eo; const f32x4 a = *(const f32x4*)kv, bq = *(const f32x4*)(kv + 4);
#pragma unroll
      for (int q = 0; q < 4; ++q) { sf[q] = Gf * sf[q] + a[q]; sf[4 + q] = Gf * sf[4 + q] + bq[q]; } }
    for (int j = N - 1; j >= n0 + 2; --j) { const float* kv = KVB + ((size_t)((cbase + j) * 8 + h) * 4096) + eo; const f32x4 a = *(const f32x4*)kv, bq = *(const f32x4*)(kv + 4);
#pragma unroll
      for (int q = 0; q < 4; ++q) { sb[q] = Gb * sb[q] + a[q]; sb[4 + q] = Gb * sb[4 + q] + bq[q]; } }
    { u32x4 w; w.x = pk2(sf[0], sf[1]); w.y = pk2(sf[2], sf[3]); w.z = pk2(sf[4], sf[5]); w.w = pk2(sf[6], sf[7]); *(LAS u32x4*)(St + 0 * 4608 + e * 72 + d0) = w; }
    { u32x4 w; w.x = pk2(sb[0], sb[1]); w.y = pk2(sb[2], sb[3]); w.z = pk2(sb[4], sb[5]); w.w = pk2(sb[6], sb[7]); *(LAS u32x4*)(St + 3 * 4608 + e * 72 + d0) = w; }
    { const float* kv = KVF + ((size_t)((cbase + n0) * 8 + h) * 4096) + eo; const f32x4 a = *(const f32x4*)kv, bq = *(const f32x4*)(kv + 4);
#pragma unroll
      for (int q = 0; q < 4; ++q) { sf[q] = Gf * sf[q] + a[q]; sf[4 + q] = Gf * sf[4 + q] + bq[q]; } }
    { const float* kv = KVB + ((size_t)((cbase + n0 + 1) * 8 + h) * 4096) + eo; const f32x4 a = *(const f32x4*)kv, bq = *(const f32x4*)(kv + 4);
#pragma unroll
      for (int q = 0; q < 4; ++q) { sb[q] = Gb * sb[q] + a[q]; sb[4 + q] = Gb * sb[4 + q] + bq[q]; } }
    { u32x4 w; w.x = pk2(sf[0], sf[1]); w.y = pk2(sf[2], sf[3]); w.z = pk2(sf[4], sf[5]); w.w = pk2(sf[6], sf[7]); *(LAS u32x4*)(St + 1 * 4608 + e * 72 + d0) = w; }
    { u32x4 w; w.x = pk2(sb[0], sb[1]); w.y = pk2(sb[2], sb[3]); w.z = pk2(sb[4], sb[5]); w.w = pk2(sb[6], sb[7]); *(LAS u32x4*)(St + 2 * 4608 + e * 72 + d0) = w; }
    if (!lat) {
      const float* kv1 = KVF + ((size_t)((cbase + 1) * 8 + h) * 4096) + eo; const float* kv0 = KVB + ((size_t)((cbase + 0) * 8 + h) * 4096) + eo;
      float* of = c.out + O_RF + ((size_t)((b * 2 + ia) * 8 + h) * 64) * 64; float* ob = c.out + O_RB + ((size_t)((b * 2 + ia) * 8 + h) * 64) * 64;
#pragma unroll
      for (int j = 0; j < 8; ++j) { of[(d0 + j) * 64 + e] = Gf * sf[j] + kv1[j]; ob[(d0 + j) * 64 + e] = Gb * sb[j] + kv0[j]; } }
  }
  __syncthreads();
  { const int cw = c.wave >> 2, r = c.lane & 31, hh = c.lane >> 5; const int iloc = 32 * (c.wave & 3) + r; const int m = 256 * p + 128 * cw + iloc;
    bf16x8 Qf[4];
#pragma unroll
    for (int ks = 0; ks < 4; ++ks) Qf[ks] = *(const bf16x8*)(Pb + (size_t)m * ACIN + h * 64 + 16 * ks + 8 * hh);
    f32x16 O0, O1;
    { const float decf = exp2f(lgf2 * (float)(iloc + 1)), decb = exp2f(lgb2 * (float)(128 - iloc));
      f32x16 f0 = zero16(), f1 = zero16();
      LAS bf16* SF = St + cw * 4608; LAS bf16* SB = St + (2 + cw) * 4608;
#pragma unroll
      for (int ks = 0; ks < 4; ++ks) { const int ko = 16 * ks + 8 * hh;
        f0 = MFMA32(*(const LAS bf16x8*)(SF + r * 72 + ko), Qf[ks], f0); f1 = MFMA32(*(const LAS bf16x8*)(SF + (32 + r) * 72 + ko), Qf[ks], f1); }
#pragma unroll
      for (int reg = 0; reg < 16; ++reg) { O0[reg] = decf * f0[reg]; O1[reg] = decf * f1[reg]; }
      f0 = zero16(); f1 = zero16();
#pragma unroll
      for (int ks = 0; ks < 4; ++ks) { const int ko = 16 * ks + 8 * hh;
        f0 = MFMA32(*(const LAS bf16x8*)(SB + r * 72 + ko), Qf[ks], f0); f1 = MFMA32(*(const LAS bf16x8*)(SB + (32 + r) * 72 + ko), Qf[ks], f1); }
#pragma unroll
      for (int reg = 0; reg < 16; ++reg) { O0[reg] += decb * f0[reg]; O1[reg] += decb * f1[reg]; } }
#pragma unroll 1
    for (int kb = 0; kb < 4; ++kb) {
      f32x16 s = zero16();
#pragma unroll
      for (int ks = 0; ks < 4; ++ks) { const bf16x8 A = *(const LAS bf16x8*)(Ks + (128 * cw + 32 * kb + r) * 72 + 16 * ks + 8 * hh); s = MFMA32(A, Qf[ks], s); }
#pragma unroll
      for (int reg = 0; reg < 16; ++reg) { const int diff = iloc - (32 * kb + crow(reg, hh));
        const float w = diff > 0 ? exp2f(lgf2 * (float)diff) : (diff < 0 ? exp2f(lgb2 * (float)(-diff)) : 2.0f); s[reg] *= w; }
#pragma unroll
      for (int sp = 0; sp < 2; ++sp) {
        u32x4 pw; pw.x = pk2(s[8 * sp + 0], s[8 * sp + 1]); pw.y = pk2(s[8 * sp + 2], s[8 * sp + 3]); pw.z = pk2(s[8 * sp + 4], s[8 * sp + 5]); pw.w = pk2(s[8 * sp + 6], s[8 * sp + 7]);
        const bf16x8 Pf = __builtin_bit_cast(bf16x8, pw);
        const int mo = 128 * cw + 32 * kb + 16 * sp + 4 * hh;
        { const s16x4 lo = *(const LAS s16x4*)(Vt + r * 264 + mo), hi = *(const LAS s16x4*)(Vt + r * 264 + mo + 8);
          O0 = MFMA32(__builtin_shufflevector(lo, hi, 0, 1, 2, 3, 4, 5, 6, 7), Pf, O0); }
        { const s16x4 lo = *(const LAS s16x4*)(Vt + (32 + r) * 264 + mo), hi = *(const LAS s16x4*)(Vt + (32 + r) * 264 + mo + 8);
          O1 = MFMA32(__builtin_shufflevector(lo, hi, 0, 1, 2, 3, 4, 5, 6, 7), Pf, O1); }
      }
    }
    float sm = 0.f;
#pragma unroll
    for (int reg = 0; reg < 16; ++reg) sm += O0[reg] + O1[reg];
    sm += __shfl_xor(sm, 32); const float mu = sm * (1.f / 64.f);
    float vs = 0.f;
#pragma unroll
    for (int reg = 0; reg < 16; ++reg) { const float a = O0[reg] - mu, bq = O1[reg] - mu; vs += a * a + bq * bq; }
    vs += __shfl_xor(vs, 32); const float rs = 1.0f / sqrtf(vs * (1.f / 64.f) + EPS);
    const bf16* gp = Pb + (size_t)m * ACIN + 1536 + h * 64; bf16* op = AO + (size_t)m * D + h * 64;
#pragma unroll
    for (int eb = 0; eb < 2; ++eb)
#pragma unroll
      for (int g = 0; g < 4; ++g) { const int e = eb * 32 + 8 * g + 4 * hh; const u32x2 gw = *(const u32x2*)(gp + e);
        float gv[4] = {bflo(gw.x), bfhi(gw.x), bflo(gw.y), bfhi(gw.y)}; float ov[4];
#pragma unroll
        for (int j = 0; j < 4; ++j) { const float o = ((eb ? O1[4 * g + j] : O0[4 * g + j]) - mu) * rs; const float gg = gv[j]; ov[j] = o * (gg / (1.f + __expf(-gg))); }
        u32x2 w; w.x = pk2(ov[0], ov[1]); w.y = pk2(ov[2], ov[3]); *(u32x2*)(op + e) = w; }
  }
  __syncthreads();
}

template <int MODE> DI void attn_item(const Ctx& c, int item, int hl) {
  constexpr int DQK = (MODE >= 2) ? 96 : 64, KS = DQK / 16, KLD = DQK + 8, VLD = 68, BUFB = 24576, VOFF = 13312;
  const int r = c.lane & 31, hh = c.lane >> 5, w = c.wave;
  const bf16* Pb = (const bf16*)(c.ws + WS_BIG);
  const bf16* KVb = (const bf16*)(c.ws + WS_BIG + BIG_KV);
  const bf16* KPE = (const bf16*)(c.ws + WS_KPE);
  const bf16* NC = (const bf16*)(c.ws + WS_NACTX);
  bf16* AO = (bf16*)(c.ws + WS_H);
  int b, h, g = 0, m, nt, nloc = 0, Rlo = 0, qr = 0, qc = 0, wsr = 0, wsc = 0;
  if (MODE == 0) { b = item >> 3; h = item & 7; m = b * 256 + 32 * w + r; nt = 4; }
  else if (MODE == 1) { b = item >> 6; h = (item >> 3) & 7; g = item & 7; qr = 4 * g + (w >> 1); qc = 32 * (w & 1) + r; m = NP + b * 2048 + qr * 64 + qc;
    Rlo = max(4 * g - 4, 0); Rlo = min(Rlo, 24); const int Rhi = min(max(4 * g - 1, 0), 24) + 7; nloc = Rhi - Rlo + 1; nt = nloc + 4;
    wsr = min(max(qr - 4, 0), 24); wsc = min(max(qc - 8, 0), 48); }
  else if (MODE == 2) { b = item >> 4; h = item & 15; m = b * 256 + 32 * w + r; nt = 4; }
  else { b = item >> 7; h = (item >> 3) & 15; g = item & 7; m = NP + b * 2048 + g * 256 + 32 * w + r; nt = 36; }
  const float sc2 = ((MODE >= 2) ? 0.10206207261596577f : 0.125f) * LOG2E;
  LAS float* rpbs = (LAS float*)(c.lds + 49152);
  if (MODE == 1) { for (int i = c.tid; i < 465; i += 512) rpbs[i] = c.in[19][(size_t)(hl * 8 + h) * 465 + i] * LOG2E; }
  bf16x8 Qf[KS]; bf16x8 Qr[2];
  if (MODE < 2) {
#pragma unroll
    for (int ks = 0; ks < KS; ++ks) Qf[ks] = *(const bf16x8*)(Pb + (size_t)m * ACIN + 2048 + h * 64 + 16 * ks + 8 * hh);
  } else {
#pragma unroll
    for (int ks = 0; ks < KS; ++ks) Qf[ks] = *(const bf16x8*)(Pb + (size_t)m * 1536 + h * 96 + 16 * ks + 8 * hh);
  }
  if (MODE == 3) { const float* RC = (const float*)(c.ws + WS_ROPE); const float* RS = RC + 32768; const int pos = g * 256 + 32 * w + r;
#pragma unroll
    for (int k2 = 0; k2 < 2; ++k2) { const f32x4 cs = *(const f32x4*)(RC + pos * 16 + 8 * k2 + 4 * hh), sn = *(const f32x4*)(RS + pos * 16 + 8 * k2 + 4 * hh);
      const u32x4 xw = __builtin_bit_cast(u32x4, Qf[4 + k2]); u32x4 ow;
#pragma unroll
      for (int q = 0; q < 4; ++q) { const float x1 = bflo(xw[q]), x2 = bfhi(xw[q]); ow[q] = pk2(x1 * cs[q] - x2 * sn[q], x1 * sn[q] + x2 * cs[q]); }
      Qr[k2] = __builtin_bit_cast(bf16x8, ow); } }
  const int skey = c.tid >> 3, spart = c.tid & 7, pkey = c.tid >> 2, ppart = c.tid & 3;
  u32x4 kreg = {0u,0u,0u,0u}, vreg = {0u,0u,0u,0u}, preg = {0u,0u,0u,0u};
#define TILE_ROW(t) ((MODE == 0 || MODE == 2) ? (b * 256 + 64 * (t)) : (MODE == 1) ? (NP + b * 2048 + (Rlo + (t)) * 64) : (((t) < 32) ? NP + b * 2048 + 64 * (t) : NT + b * 256 + 64 * ((t) - 32)))
#define LOAD_TILE(t) do { \
    if (MODE == 0 || (MODE == 1 && (t) < nloc)) { const bf16* rp_ = Pb + (size_t)(TILE_ROW(t) + skey) * ACIN + h * 64 + spart * 8; kreg = *(const u32x4*)(rp_ + 2560); vreg = *(const u32x4*)(rp_ + 3072); } \
    else if (MODE == 1) { const int tc_ = (t) - nloc; const size_t base_ = ((size_t)((hl * 2 + 0) * 8 + b) * 8 + h) * 16384 + (size_t)(64 * tc_ + skey) * 64 + spart * 8; \
      kreg = *(const u32x4*)(NC + base_); vreg = *(const u32x4*)(NC + base_ + (size_t)8 * 8 * 16384); } \
    else { const int row_ = TILE_ROW(t); const bf16* rp_ = KVb + (size_t)(row_ + skey) * 2048 + h * 64 + spart * 8; kreg = *(const u32x4*)rp_; vreg = *(const u32x4*)(rp_ + 1024); \
      if (c.tid < 256) preg = *(const u32x4*)(KPE + (size_t)(row_ + pkey) * 32 + ppart * 8); } } while (0)
#define STORE_TILE(bufi) do { \
    LAS bf16* Ks_ = (LAS bf16*)(c.lds + (bufi) * BUFB); LAS bf16* Vt_ = (LAS bf16*)(c.lds + (bufi) * BUFB + VOFF); \
    *(LAS u32x4*)(Ks_ + skey * KLD + spart * 8) = kreg; \
    if (MODE >= 2) { if (c.tid < 256) *(LAS u32x4*)(Ks_ + pkey * KLD + 64 + ppart * 8) = preg; } \
    _Pragma("unroll") for (int j_ = 0; j_ < 4; ++j_) { const int e0_ = (spart * 8 + 2 * j_) * VLD + skey; Vt_[e0_] = (bf16)(vreg[j_] & 0xffffu); Vt_[e0_ + VLD] = (bf16)(vreg[j_] >> 16); } } while (0)
  f32x16 O0 = zero16(), O1 = zero16();
  float mrun = -1e30f, lrun = 0.f;
  LOAD_TILE(0); STORE_TILE(0);
  __syncthreads();
  for (int t = 0; t < nt; ++t) {
    if (t + 1 < nt) LOAD_TILE(t + 1);
    bool active = true; int R = 0;
    if (MODE == 1 && t < nloc) { R = Rlo + t; active = (R >= wsr) && (R < wsr + 8); }
    if (active) {
      LAS bf16* Ks = (LAS bf16*)(c.lds + (t & 1) * BUFB); LAS bf16* Vt = (LAS bf16*)(c.lds + (t & 1) * BUFB + VOFF);
      f32x16 s0 = zero16(), s1 = zero16();
      const bool rot = (MODE == 3) && (t < 32);
#pragma unroll
      for (int ks = 0; ks < KS; ++ks) { bf16x8 q = Qf[ks]; if (MODE == 3 && ks >= 4) q = rot ? Qr[ks - 4] : Qf[ks];
        const bf16x8 A0 = *(const LAS bf16x8*)(Ks + r * KLD + 16 * ks + 8 * hh); const bf16x8 A1 = *(const LAS bf16x8*)(Ks + (32 + r) * KLD + 16 * ks + 8 * hh);
        s0 = MFMA32(A0, q, s0); s1 = MFMA32(A1, q, s1); }
      float tmax = -1e30f;
      if (MODE == 1 && t < nloc) {
        const int dro = (R - qr + 7) * 31;
#pragma unroll
        for (int reg = 0; reg < 16; ++reg) { const int k0 = crow(reg, hh), k1 = 32 + k0;
          const bool v0 = (k0 >= wsc) && (k0 < wsc + 16), v1 = (k1 >= wsc) && (k1 < wsc + 16);
          const float b0 = rpbs[v0 ? dro + k0 - qc + 15 : 0], b1 = rpbs[v1 ? dro + k1 - qc + 15 : 0];
          s0[reg] = v0 ? s0[reg] * sc2 + b0 : -1e30f; s1[reg] = v1 ? s1[reg] * sc2 + b1 : -1e30f;
          tmax = fmaxf(tmax, fmaxf(s0[reg], s1[reg])); }
      } else {
#pragma unroll
        for (int reg = 0; reg < 16; ++reg) { s0[reg] *= sc2; s1[reg] *= sc2; tmax = fmaxf(tmax, fmaxf(s0[reg], s1[reg])); }
      }
      tmax = fmaxf(tmax, __shfl_xor(tmax, 32));
      const float mnew = fmaxf(mrun, tmax); const float alpha = exp2f(mrun - mnew); mrun = mnew;
      float ps = 0.f;
#pragma unroll
      for (int reg = 0; reg < 16; ++reg) { s0[reg] = exp2f(s0[reg] - mnew); s1[reg] = exp2f(s1[reg] - mnew); ps += s0[reg] + s1[reg]; }
      lrun = lrun * alpha + ps;
#pragma unroll
      for (int reg = 0; reg < 16; ++reg) { O0[reg] *= alpha; O1[reg] *= alpha; }
#pragma unroll
      for (int kb = 0; kb < 2; ++kb)
#pragma unroll
        for (int sp = 0; sp < 2; ++sp) {
          u32x4 pw;
          if (kb == 0) { pw.x = pk2(s0[8 * sp + 0], s0[8 * sp + 1]); pw.y = pk2(s0[8 * sp + 2], s0[8 * sp + 3]); pw.z = pk2(s0[8 * sp + 4], s0[8 * sp + 5]); pw.w = pk2(s0[8 * sp + 6], s0[8 * sp + 7]); }
          else { pw.x = pk2(s1[8 * sp + 0], s1[8 * sp + 1]); pw.y = pk2(s1[8 * sp + 2], s1[8 * sp + 3]); pw.z = pk2(s1[8 * sp + 4], s1[8 * sp + 5]); pw.w = pk2(s1[8 * sp + 6], s1[8 * sp + 7]); }
          const bf16x8 Pf = __builtin_bit_cast(bf16x8, pw);
          const int mo = 32 * kb + 16 * sp + 4 * hh;
          { const s16x4 lo = *(const LAS s16x4*)(Vt + r * VLD + mo), hi = *(const LAS s16x4*)(Vt + r * VLD + mo + 8);
            O0 = MFMA32(__builtin_shufflevector(lo, hi, 0, 1, 2, 3, 4, 5, 6, 7), Pf, O0); }
          { const s16x4 lo = *(const LAS s16x4*)(Vt + (32 + r) * VLD + mo), hi = *(const LAS s16x4*)(Vt + (32 + r) * VLD + mo + 8);
            O1 = MFMA32(__builtin_shufflevector(lo, hi, 0, 1, 2, 3, 4, 5, 6, 7), Pf, O1); }
        }
    }
    if (t + 1 < nt) STORE_TILE((t + 1) & 1);
    __syncthreads();
  }
  { const float ltot = lrun + __shfl_xor(lrun, 32); const float inv = 1.0f / ltot;
    bf16* op = AO + (size_t)m * D + ((MODE < 2) ? 512 : 0) + h * 64;
#pragma unroll
    for (int eb = 0; eb < 2; ++eb)
#pragma unroll
      for (int gq = 0; gq < 4; ++gq) { const int e = eb * 32 + 8 * gq + 4 * hh;
        u32x2 wv; if (eb == 0) { wv.x = pk2(O0[4 * gq] * inv, O0[4 * gq + 1] * inv); wv.y = pk2(O0[4 * gq + 2] * inv, O0[4 * gq + 3] * inv); }
        else { wv.x = pk2(O1[4 * gq] * inv, O1[4 * gq + 1] * inv); wv.y = pk2(O1[4 * gq + 2] * inv, O1[4 * gq + 3] * inv); }
        *(u32x2*)(op + e) = wv; } }
  __syncthreads();
}

__global__ void __launch_bounds__(512, 2) mk_fwd(Args a) {
  extern __shared__ __attribute__((aligned(16))) unsigned char lds_raw[];
  cg::grid_group grid = cg::this_grid();
#define MAKE_CTX() Ctx c; { unsigned long long wsp_ = (unsigned long long)a.ws, outp_ = (unsigned long long)a.out; int z_ = 0; int tid_ = threadIdx.x; int g_ = gridDim.x, b_ = blockIdx.x; \
    asm volatile("" : "+s"(wsp_), "+s"(outp_), "+s"(z_), "+s"(g_), "+s"(b_)); asm volatile("" : "+v"(tid_)); \
    c.in = a.in + z_; c.out = (float*)outp_; c.ws = (unsigned char*)wsp_; c.lds = (lptr)lds_raw; c.tid = tid_; c.lane = tid_ & 63; c.wave = __builtin_amdgcn_readfirstlane(tid_ >> 6); c.G = g_; c.bid = b_; } \
    unsigned char* ws = c.ws; bf16* Hb = (bf16*)(ws + WS_H); float* Yb = (float*)(ws + WS_Y); unsigned char* BIG = ws + WS_BIG; unsigned char* WA = ws + WS_WA; (void)Hb; (void)Yb; (void)BIG; (void)WA;
#if !defined(PHASE_MASK) || (PHASE_MASK & 1)
  { MAKE_CTX(); prologue(c); }
  grid.sync();
  { MAKE_CTX(); row_phase(c, 0, 0); }
  grid.sync();
#endif

  for (int l = 0; l < 4; ++l) {
    const int odd = l & 1, hl = l >> 1;
    const unsigned long long prog = odd ? 0x74654A984ull : 0x74654321ull;
    for (int st = 0; st < 9; ++st) {
      const int op = (int)((prog >> (4 * st)) & 15ull);
      if (op == 0) break;
#ifdef PHASE_MASK
      if (!((PHASE_MASK >> op) & 1)) continue;
#endif
      if (op == 1) { MAKE_CTX();
        pg8::Gemm g{Hb, (const bf16*)WA, NT, ACIN, D}; pg8::StaticOrder S; S.init(NT, ACIN, c.G, c.bid);
        pg8::EpiBf16<2> E{(bf16*)BIG, ACIN, c.out + O_NK + (size_t)hl * 8 * 256 * 64, c.out + O_NV + (size_t)hl * 8 * 256 * 64};
        pg8::gemm_phase(c.lds, g, S, E, c.tid);
      } else if (op == 2) { MAKE_CTX();
        for (int it = c.bid; it < 768 + 256 + 512; it += c.G) {
          if (it < 768) ret_kv_item(c, it, hl);
          else if (it < 1024) attn_item<0>(c, it - 768, hl);
          else attn_item<1>(c, it - 1024, hl);
        }
      } else if (op == 3) { MAKE_CTX();
        for (int it = c.bid; it < 768; it += c.G) ret_out_item(c, it, hl);
      } else if (op == 4) { MAKE_CTX();
        const bool inproj = odd && st == 0, outproj = (!odd && st == 3) || (odd && st == 4);
        pg8::Gemm g; pg8::EpiF32 E;
        if (inproj) { g = pg8::Gemm{Hb, (const bf16*)WA, NT, CINP, D}; E = pg8::EpiF32{(float*)BIG, CINP}; }
        else if (outproj) { g = pg8::Gemm{Hb, (const bf16*)(WA + (odd ? WA_OUT_O : WA_OUT_E)), NT, D, D}; E = pg8::EpiF32{Yb, D}; }
        else { g = pg8::Gemm{(const bf16*)BIG, (const bf16*)(ws + WS_W2T), NT, D, FF}; E = pg8::EpiF32{Yb, D}; }
        pg8::StaticOrder S; S.init(g.M, g.N, c.G, c.bid);
        pg8::gemm_phase(c.lds, g, S, E, c.tid);
      } else if (op == 5) { MAKE_CTX();
        row_phase(c, l, 1);
      } else if (op == 6) { MAKE_CTX();
        pg8::Gemm g{Hb, (const bf16*)(ws + WS_W1T), NT, FF, D}; pg8::StaticOrder S; S.init(NT, FF, c.G, c.bid);
        pg8::EpiBf16<1> E{(bf16*)BIG, FF, nullptr, nullptr};
        pg8::gemm_phase(c.lds, g, S, E, c.tid);
      } else if (op == 7) { MAKE_CTX();
        row_phase(c, l, 2);
        if (l < 3) convert_weights(c, l + 1);
      } else if (op == 8) { MAKE_CTX();
        mla_rows(c, hl);
      } else if (op == 9) { MAKE_CTX();
        for (int j = 0; j < 2; ++j) {
          pg8::Gemm g = j ? pg8::Gemm{(const bf16*)(ws + WS_H + H_CKVN), (const bf16*)(WA + WA_UKV), NT + NCTX, 2048, 256}
                          : pg8::Gemm{Hb, (const bf16*)(WA + WA_UQ), NT, 1536, 384};
          pg8::EpiBf16<0> E{j ? (bf16*)(BIG + BIG_KV) : (bf16*)BIG, j ? 2048 : 1536, nullptr, nullptr};
          pg8::StaticOrder S; S.init(g.M, g.N, c.G, c.bid);
          pg8::gemm_phase(c.lds, g, S, E, c.tid);
        }
      } else if (op == 10) { MAKE_CTX();
        for (int it = c.bid; it < 512 + 1024; it += c.G) {
          if (it < 512) attn_item<2>(c, it, hl); else attn_item<3>(c, it - 512, hl);
        }
      }
      grid.sync();
    }
  }
}

extern "C" void kernel_launch(void* const* d_in, const int* in_sizes, int n_in, void* d_out, int out_size, void* d_ws, size_t ws_size, hipStream_t stream) {
  static int grid = 0;
  if (grid == 0) {
    if (n_in != 27 || out_size != 50855936 || ws_size < WS_END) { fprintf(stderr, "kernel_launch: unexpected shapes (n_in %d out %d ws %zu)\n", n_in, out_size, ws_size); grid = -1; return; }
    int dev = 0, cus = 0, per_cu = 0;
    if (hipGetDevice(&dev) != hipSuccess || hipDeviceGetAttribute(&cus, hipDeviceAttributeMultiprocessorCount, dev) != hipSuccess) { grid = -1; return; }
    if (hipFuncSetAttribute((const void*)mk_fwd, hipFuncAttributeMaxDynamicSharedMemorySize, LDS_BYTES) != hipSuccess) { fprintf(stderr, "kernel_launch: hipFuncSetAttribute failed\n"); grid = -1; return; }
    if (hipOccupancyMaxActiveBlocksPerMultiprocessor(&per_cu, (const void*)mk_fwd, 512, LDS_BYTES) != hipSuccess || per_cu < 1) { fprintf(stderr, "kernel_launch: occupancy query says %d\n", per_cu); per_cu = 1; }
    (void)hipGetLastError();
    grid = cus;
  }
  if (grid < 0) return;
  Args a{};
  for (int i = 0; i < 27; ++i) a.in[i] = (const float*)d_in[i];
  a.out = (float*)d_out; a.ws = (unsigned char*)d_ws;
  void* args[] = {&a};
  hipError_t e = hipLaunchCooperativeKernel((const void*)mk_fwd, dim3(grid), dim3(512), args, LDS_BYTES, stream);
  if (e != hipSuccess) fprintf(stderr, "kernel_launch: cooperative launch failed: %s\n", hipGetErrorString(e));
}
```

```cpp
#include <hip/hip_runtime.h>
#include <hip/hip_cooperative_groups.h>
#include <cstdio>
namespace cg = cooperative_groups;

#define DI __device__ __forceinline__
#define LAS __attribute__((address_space(3)))
typedef unsigned short bf16;
typedef short bf16x8 __attribute__((ext_vector_type(8)));
typedef short s16x4 __attribute__((ext_vector_type(4)));
typedef float f32x4 __attribute__((ext_vector_type(4)));
typedef float f32x2 __attribute__((ext_vector_type(2)));
typedef float f32x16 __attribute__((ext_vector_type(16)));
typedef unsigned u32x4 __attribute__((ext_vector_type(4)));
typedef unsigned u32x2 __attribute__((ext_vector_type(2)));
typedef __bf16 bf16x2_t __attribute__((ext_vector_type(2)));
typedef LAS unsigned char* lptr;

#define LDS_WAIT() asm volatile("s_waitcnt lgkmcnt(0)" ::: "memory")
#define MFMA32(a, b, c) __builtin_amdgcn_mfma_f32_32x32x16_bf16((a), (b), (c), 0, 0, 0)

DI unsigned pk2(float lo, float hi) { f32x2 v = {lo, hi}; bf16x2_t b = __builtin_convertvector(v, bf16x2_t); return __builtin_bit_cast(unsigned, b); }
DI bf16 f2bf(float f) { return (bf16)(pk2(f, 0.f) & 0xffffu); }
DI float bf2f(unsigned b) { return __builtin_bit_cast(float, (b & 0xffffu) << 16); }
DI float bflo(unsigned w) { return __builtin_bit_cast(float, w << 16); }
DI float bfhi(unsigned w) { return __builtin_bit_cast(float, w & 0xffff0000u); }
DI float wave_sum(float v) {
#pragma unroll
  for (int o = 1; o < 64; o <<= 1) v += __shfl_xor(v, o);
  return v;
}
DI s16x4 tr_read(const LAS bf16* p) { return __builtin_amdgcn_ds_read_tr16_b64_v4i16((LAS s16x4*)p); }
DI bf16x8 cat8(s16x4 lo, s16x4 hi) { return __builtin_shufflevector(lo, hi, 0, 1, 2, 3, 4, 5, 6, 7); }
DI float fmax_nc(float a, float b) { return __builtin_amdgcn_fmed3f(a, b, __builtin_inff()); }
DI int crow(int reg, int h) { return (reg & 3) + 8 * (reg >> 2) + 4 * h; }
DI f32x16 zero16() { f32x16 z; for (int i = 0; i < 16; ++i) z[i] = 0.f; return z; }

constexpr int D = 1024, NP = 8192, NS = 16384, NT = 24576, FF = 4096, ACIN = 3584, CINP = 768, NCTX = 2048;
constexpr float EPS = 1e-6f, LOG2E = 1.4426950408889634f;
constexpr size_t O_RF = 25165824, O_RB = 27262976, O_NK = 29360128, O_NV = 37748736, O_CKV = 46137344, O_KPE = 50331648;
constexpr size_t MiB = 1u << 20;
constexpr size_t WS_MOD = 1 * MiB, WS_ROPE = 2 * MiB, WS_KPE = 3 * MiB, WS_NACTX = 5 * MiB;
constexpr size_t WS_W1T = 13 * MiB, WS_W2T = 21 * MiB, WS_WA = 29 * MiB;
constexpr size_t WS_H = 40 * MiB, WS_Y = 88 * MiB, WS_BIG = 184 * MiB, WS_END = 376 * MiB;
constexpr size_t WA_OUT_E = 7 * MiB, WA_UQ = 1536 * 1024, WA_UKV = 3 * MiB, WA_OUT_O = 4 * MiB;
constexpr size_t H_CKVN = 20 * MiB;
constexpr size_t Y_KVB = 24 * MiB;
constexpr size_t BIG_KV = 72 * MiB;
constexpr int LDS_BYTES = 147456;

struct Args { const float* in[27]; float* out; unsigned char* ws; unsigned long long use_cg; };

namespace pg8 {
constexpr int BM = 256, BK = 64, HALF = 128, HTB = HALF * BK * 2, NXCD = 8, WGM = 8;
DI int lds_byte(int r, int c) { const int st = (r >> 4) * 2 + (c >> 5), rr = r & 15, cc = c & 31, ob = rr * 64 + cc * 2; return st * 1024 + (ob ^ (((ob >> 9) & 1) << 5)); }
DI void stage_rc(int b, int& R, int& C) { const int st = b / 1024, sb = b % 1024, swz = sb ^ (((sb >> 9) & 1) << 5); R = (st >> 1) * 16 + swz / 64; C = (st & 1) * 32 + (swz % 64) / 2; }
DI int perm32(int rho) { const int n = rho >> 4, i = rho & 15; return 8 * (i >> 2) + 4 * n + (i & 3); }
struct Unit { int pm, pn; };
struct Gemm { const bf16* A; const bf16* Bt; int M, N, K, lda, ldb, nNreal; };
struct StaticOrder {
  int nM, nN, nwg, G, c;
  DI void init(int M, int N, int G_, int c_) { nM = M / BM; nN = N / BM; nwg = nM * nN; G = G_; c = c_; }
  DI bool next(int i, Unit& u) const {
    const long L = (long)i * G + c; if (L >= nwg) return false;
    int wgid = (int)L; { const int q = nwg / NXCD, r = nwg % NXCD, xcd = wgid % NXCD, off = wgid / NXCD; wgid = (xcd < r ? xcd * (q + 1) : r * (q + 1) + (xcd - r) * q) + off; }
    const int nig = WGM * nN, gid = wgid / nig, fm = gid * WGM, gsz = (nM - fm) < WGM ? (nM - fm) : WGM;
    u.pm = fm + ((wgid % nig) % gsz); u.pn = (wgid % nig) / gsz; return true;
  }
};
struct EpiF32 {
  static constexpr bool PERM = false;
  float* C; int ldc;
  DI void operator()(const f32x4 (&acc)[2][2][4][2], const Unit& u, int wr, int wc, int fr, int fq) const {
    const int row0 = u.pm * BM + wr * 64 + fr, col0 = u.pn * BM + wc * 32 + 4 * fq;
#pragma unroll
    for (int ai = 0; ai < 2; ++ai)
#pragma unroll
      for (int m = 0; m < 4; ++m) { float* rowp = C + (size_t)(row0 + ai * HALF + m * 16) * ldc + col0;
#pragma unroll
        for (int bj = 0; bj < 2; ++bj)
#pragma unroll
          for (int n = 0; n < 2; ++n) *(f32x4*)(rowp + bj * HALF + n * 16) = acc[ai][bj][m][n]; }
  }
};
template <int MODE> struct EpiBf16 {
  static constexpr bool PERM = true;
  bf16* O; int ldc; float* nk_out; float* nv_out;
  DI void operator()(const f32x4 (&acc)[2][2][4][2], const Unit& u, int wr, int wc, int fr, int fq) const {
    const int row0 = u.pm * BM + wr * 64 + fr; const int col0 = u.pn * BM + wc * 32 + 8 * fq;
    const float sc = (MODE == 2 && (u.pn == 2 || u.pn == 3)) ? 0.125f : 1.0f;
    const bool side = (MODE == 2) && (u.pn >= 10) && (u.pm < 32);
    float* sbase = (u.pn >= 12) ? nv_out : nk_out;
    const int scol0 = col0 - ((u.pn >= 12) ? 3072 : 2560);
#pragma unroll
    for (int ai = 0; ai < 2; ++ai)
#pragma unroll
      for (int m = 0; m < 4; ++m) { const int row = row0 + ai * HALF + m * 16; bf16* rowp = O + (size_t)row * ldc + col0;
#pragma unroll
        for (int bj = 0; bj < 2; ++bj) { f32x4 v0 = acc[ai][bj][m][0], v1 = acc[ai][bj][m][1];
          if (MODE == 1) {
#pragma unroll
            for (int j = 0; j < 4; ++j) { float a = fmaxf(v0[j], 0.f), b = fmaxf(v1[j], 0.f); v0[j] = a * a; v1[j] = b * b; } }
          if (MODE == 2) { v0 = v0 * sc; v1 = v1 * sc; }
          u32x4 w; w.x = pk2(v0[0], v0[1]); w.y = pk2(v0[2], v0[3]); w.z = pk2(v1[0], v1[1]); w.w = pk2(v1[2], v1[3]);
          *(u32x4*)(rowp + bj * HALF) = w;
          if (MODE == 2) { if (side) { const int cc = scol0 + bj * HALF; const int hh = cc >> 6, dd = cc & 63; const int b = row >> 8, s = row & 255;
              float* dst = sbase + ((size_t)((b * 2) * 8 + hh) * 256 + s) * 64 + dd;
              *(f32x4*)dst = v0; *(f32x4*)(dst + 4) = v1; } }
        } }
  }
};

template <class Epi>
DI void gemm_phase(lptr lds, const Gemm g, const StaticOrder& S, const Epi& E, const int tid) {
  const int wid = __builtin_amdgcn_readfirstlane(tid >> 6), lane = tid & 63, wr = wid >> 2, wc = wid & 3, fr = lane & 15, fq = lane >> 4;
  const int K = g.K, nt = K / BK;
  unsigned voffA[2], voffB[2];
#pragma unroll
  for (int i = 0; i < 2; ++i) { int R, C; stage_rc(tid * 16 + i * 8192, R, C); const int Rb = Epi::PERM ? ((R & ~31) + perm32(R & 31)) : R;
    voffA[i] = (unsigned)(R * g.lda + C) * 2u; voffB[i] = (unsigned)(Rb * g.ldb + C) * 2u; }
  const size_t kstep = (size_t)(BK * 2);
  const size_t hstepA = (size_t)HALF * g.lda * 2, hstepB = (size_t)HALF * g.ldb * 2;
  const size_t tstepA = 2 * hstepA, tstepB = 2 * hstepB; const int nNr = g.nNreal; const size_t ksl = (size_t)K * 2;
  const unsigned ldsw = (unsigned)wid * 1024u;
  const int aoff = lds_byte(wr * 64 + fr, fq * 8), boff = lds_byte(wc * 32 + fr, fq * 8);
#define PG8_SA(b, h) (((b) * 2 + (h)) * HTB)
#define PG8_SB(b, h) ((4 + (b) * 2 + (h)) * HTB)
#define PG8_STAGE(bufoff, gbase, voff) do { _Pragma("unroll") for (int _i = 0; _i < 2; ++_i) \
    __builtin_amdgcn_global_load_lds((const unsigned*)((const char*)(gbase) + (voff)[_i]), (LAS unsigned*)(lds + (bufoff) + ldsw + _i * 8192), 16, 0, 0); } while (0)
#define PG8_LDA(dst, b, h) do { _Pragma("unroll") for (int m = 0; m < 4; ++m) _Pragma("unroll") for (int k = 0; k < 2; ++k) dst[m][k] = *(const LAS bf16x8*)(lds + PG8_SA(b, h) + aoff + m * 2048 + k * 1024); } while (0)
#define PG8_LDB(dst, b, h) do { _Pragma("unroll") for (int n = 0; n < 2; ++n) _Pragma("unroll") for (int k = 0; k < 2; ++k) dst[n][k] = *(const LAS bf16x8*)(lds + PG8_SB(b, h) + boff + n * 2048 + k * 1024); } while (0)
#define PG8_MMA(ai, bj, At, Bt) do { __builtin_amdgcn_s_setprio(1); _Pragma("unroll") for (int m = 0; m < 4; ++m) _Pragma("unroll") for (int n = 0; n < 2; ++n) _Pragma("unroll") for (int k = 0; k < 2; ++k) \
    acc[ai][bj][m][n] = __builtin_amdgcn_mfma_f32_16x16x32_bf16(Bt[n][k], At[m][k], acc[ai][bj][m][n], 0, 0, 0); __builtin_amdgcn_s_setprio(0); } while (0)
#define PG8_WAIT_V(n) asm volatile("s_waitcnt vmcnt(" #n ")" ::: "memory")
#define PG8_WAIT_L(n) asm volatile("s_waitcnt lgkmcnt(" #n ")" ::: "memory")
#define PG8_BAR __builtin_amdgcn_s_barrier()
#define PG8_SCHED __builtin_amdgcn_sched_barrier(0)
  Unit cur, nxt; int ui = 0;
  if (!S.next(0, cur)) return;
  f32x4 acc[2][2][4][2];
#pragma unroll
  for (int a = 0; a < 2; ++a)
#pragma unroll
    for (int b = 0; b < 2; ++b)
#pragma unroll
      for (int m = 0; m < 4; ++m)
#pragma unroll
        for (int n = 0; n < 2; ++n) acc[a][b][m][n] = (f32x4){0.f, 0.f, 0.f, 0.f};
  bf16x8 At[4][2], B0[2][2], B1[2][2];
  const char* cA = (const char*)g.A + (size_t)cur.pm * tstepA + (size_t)(cur.pn / nNr) * ksl; const char* cB = (const char*)g.Bt + (size_t)(cur.pn % nNr) * tstepB + (size_t)(cur.pn / nNr) * ksl;
  PG8_STAGE(PG8_SB(0, 0), cB, voffB); PG8_STAGE(PG8_SA(0, 0), cA, voffA); PG8_STAGE(PG8_SB(0, 1), cB + hstepB, voffB); PG8_STAGE(PG8_SA(0, 1), cA + hstepA, voffA);
  if (wr == 1) PG8_BAR;
  PG8_WAIT_V(4); PG8_BAR;
  PG8_STAGE(PG8_SB(1, 0), cB + kstep, voffB); PG8_STAGE(PG8_SA(1, 0), cA + kstep, voffA); PG8_STAGE(PG8_SB(1, 1), cB + hstepB + kstep, voffB);
  PG8_WAIT_V(6); PG8_BAR;
  for (;;) {
    const bool has_next = S.next(ui + 1, nxt);
    const char* nA = has_next ? (const char*)g.A + (size_t)nxt.pm * tstepA + (size_t)(nxt.pn / nNr) * ksl : cA; const char* nB = has_next ? (const char*)g.Bt + (size_t)(nxt.pn % nNr) * tstepB + (size_t)(nxt.pn / nNr) * ksl : cB;
    for (int t = 0; t < nt; t += 2) {
      const bool last = (t == nt - 2);
      const char* a1 = cA + (size_t)(t + 1) * kstep;
      const char* a2 = last ? nA : cA + (size_t)(t + 2) * kstep; const char* b2 = last ? nB : cB + (size_t)(t + 2) * kstep;
      const char* a3 = a2 + kstep; const char* b3 = b2 + kstep;
      PG8_LDB(B0, 0, 0); PG8_SCHED; PG8_LDA(At, 0, 0); PG8_STAGE(PG8_SA(1, 1), a1 + hstepA, voffA);
      PG8_WAIT_L(8); PG8_BAR; PG8_WAIT_L(0); PG8_MMA(0, 0, At, B0); PG8_BAR; PG8_SCHED;
      PG8_LDB(B1, 0, 1); PG8_STAGE(PG8_SB(0, 0), b2, voffB);
      PG8_BAR; PG8_WAIT_L(0); PG8_MMA(0, 1, At, B1); PG8_BAR;
      PG8_LDA(At, 0, 1); PG8_STAGE(PG8_SA(0, 0), a2, voffA);
      PG8_BAR; PG8_WAIT_L(0); PG8_MMA(1, 0, At, B0); PG8_BAR; PG8_SCHED;
      PG8_STAGE(PG8_SB(0, 1), b2 + hstepB, voffB);
      PG8_WAIT_V(6); PG8_BAR; PG8_MMA(1, 1, At, B1); PG8_BAR;
      PG8_LDB(B0, 1, 0); PG8_SCHED; PG8_LDA(At, 1, 0); PG8_STAGE(PG8_SA(0, 1), a2 + hstepA, voffA);
      PG8_WAIT_L(8); PG8_BAR; PG8_WAIT_L(0); PG8_MMA(0, 0, At, B0); PG8_BAR; PG8_SCHED;
      PG8_LDB(B1, 1, 1); PG8_STAGE(PG8_SB(1, 0), b3, voffB);
      PG8_BAR; PG8_WAIT_L(0); PG8_MMA(0, 1, At, B1); PG8_BAR;
      PG8_LDA(At, 1, 1); PG8_STAGE(PG8_SA(1, 0), a3, voffA);
      PG8_BAR; PG8_WAIT_L(0); PG8_MMA(1, 0, At, B0); PG8_BAR; PG8_SCHED;
      PG8_STAGE(PG8_SB(1, 1), b3 + hstepB, voffB);
      PG8_WAIT_V(6); PG8_BAR; PG8_MMA(1, 1, At, B1); PG8_BAR;
    }
    E(acc, cur, wr, wc, fr, fq);
    if (!has_next) break;
#pragma unroll
    for (int a = 0; a < 2; ++a)
#pragma unroll
      for (int b = 0; b < 2; ++b)
#pragma unroll
        for (int m = 0; m < 4; ++m)
#pragma unroll
          for (int n = 0; n < 2; ++n) acc[a][b][m][n] = (f32x4){0.f, 0.f, 0.f, 0.f};
    cur = nxt; cA = nA; cB = nB; ++ui;
  }
  PG8_WAIT_V(0);
  if (wr == 0) PG8_BAR;
  PG8_BAR;
#undef PG8_SA
#undef PG8_SB
#undef PG8_STAGE
#undef PG8_LDA
#undef PG8_LDB
#undef PG8_MMA
#undef PG8_WAIT_V
#undef PG8_WAIT_L
#undef PG8_BAR
#undef PG8_SCHED
}
}

struct Ctx {
  const float* const* in; float* out; unsigned char* ws; lptr lds;
  int tid, lane, wave, G, bid, zero;
};
DI float log_decay2(float p) { return log1pf(-exp2f(p)) * LOG2E; }

DI void transpose_item(const float* W, int K, int N, bf16* WT, int row_off, LAS float* scr, int item, int lane) {
  const int nblk = N / 32, kb = item / nblk, nb = item % nblk, k0 = 64 * kb, n0 = 32 * nb;
  float tv[32];
#pragma unroll
  for (int i = 0; i < 32; ++i) { const int kk = 2 * i + (lane >> 5); tv[i] = W[(size_t)(k0 + kk) * N + n0 + (lane & 31)]; }
#pragma unroll
  for (int i = 0; i < 32; ++i) { const int kk = 2 * i + (lane >> 5); scr[kk * 33 + (lane & 31)] = tv[i]; }
  LDS_WAIT(); asm volatile("" ::: "memory");
  const int c = lane & 7;
#pragma unroll
  for (int j = 0; j < 4; ++j) { const int n = (lane >> 3) + 8 * j; const LAS float* s = scr + (8 * c) * 33 + n;
    u32x4 o; o.x = pk2(s[0 * 33], s[1 * 33]); o.y = pk2(s[2 * 33], s[3 * 33]); o.z = pk2(s[4 * 33], s[5 * 33]); o.w = pk2(s[6 * 33], s[7 * 33]);
    *(u32x4*)(WT + (size_t)(row_off + n0 + n) * K + k0 + 8 * c) = o; }
  LDS_WAIT(); asm volatile("" ::: "memory");
}
DI void convert_weights(const Ctx& c, int l) {
  LAS float* scr = (LAS float*)(c.lds + c.wave * 16384);
  const int gw = c.bid * 8 + c.wave, NGW = c.G * 8;
  bf16* W1T = (bf16*)(c.ws + WS_W1T); bf16* W2T = (bf16*)(c.ws + WS_W2T); unsigned char* WA = c.ws + WS_WA;
  const int hl = l >> 1;
  const float* w1 = c.in[13] + (size_t)l * D * FF; const float* w2 = c.in[14] + (size_t)l * FF * D;
  constexpr int I1 = 16 * 128, I2 = 64 * 32;
  if ((l & 1) == 0) {
    const float* win = c.in[15] + (size_t)hl * D * ACIN; const float* wout = c.in[16] + (size_t)hl * D * D;
    constexpr int IA = 16 * 112, IB = 16 * 32;
    for (int it = gw; it < I1 + I2 + IA + IB; it += NGW) {
      int r = it;
      if (r < I1) { transpose_item(w1, D, FF, W1T, 0, scr, r, c.lane); continue; } r -= I1;
      if (r < I2) { transpose_item(w2, FF, D, W2T, 0, scr, r, c.lane); continue; } r -= I2;
      if (r < IA) { transpose_item(win, D, ACIN, (bf16*)WA, 0, scr, r, c.lane); continue; } r -= IA;
      transpose_item(wout, D, D, (bf16*)(WA + WA_OUT_E), 0, scr, r, c.lane);
    }
  } else {
    const float* winc = c.in[20] + (size_t)hl * D * 672; const float* wuq = c.in[23] + (size_t)hl * 384 * 1536;
    const float* wuk = c.in[24] + (size_t)hl * 256 * 1024; const float* wuv = c.in[25] + (size_t)hl * 256 * 1024; const float* woc = c.in[26] + (size_t)hl * D * D;
    constexpr int IA = 16 * 21, IB = 6 * 48, IC = 4 * 32, ID = 16 * 32;
    for (int it = gw; it < I1 + I2 + IA + IB + 2 * IC + ID; it += NGW) {
      int r = it;
      if (r < I1) { transpose_item(w1, D, FF, W1T, 0, scr, r, c.lane); continue; } r -= I1;
      if (r < I2) { transpose_item(w2, FF, D, W2T, 0, scr, r, c.lane); continue; } r -= I2;
      if (r < IA) { transpose_item(winc, D, 672, (bf16*)WA, 0, scr, r, c.lane); continue; } r -= IA;
      if (r < IB) { transpose_item(wuq, 384, 1536, (bf16*)(WA + WA_UQ), 0, scr, r, c.lane); continue; } r -= IB;
      if (r < IC) { transpose_item(wuk, 256, 1024, (bf16*)(WA + WA_UKV), 0, scr, r, c.lane); continue; } r -= IC;
      if (r < IC) { transpose_item(wuv, 256, 1024, (bf16*)(WA + WA_UKV), 1024, scr, r, c.lane); continue; } r -= IC;
      transpose_item(woc, D, D, (bf16*)(WA + WA_OUT_O), 0, scr, r, c.lane);
    }
    u32x4* z = (u32x4*)(WA + (size_t)672 * D * 2);
    for (int i = c.bid * 512 + c.tid; i < 96 * D * 2 / 16; i += c.G * 512) z[i] = (u32x4){(unsigned)c.zero, (unsigned)c.zero, (unsigned)c.zero, (unsigned)c.zero};
  }
}

DI void prologue(const Ctx& c) {
  float* MOD = (float*)(c.ws + WS_MOD);
  for (int item = c.bid; item < 4 * 48; item += c.G) {
    const int l = item / 48, n0 = (item % 48) * 128;
    LAS float* sil = (LAS float*)c.lds; LAS float* red = (LAS float*)(c.lds + 36864);
    for (int i = c.tid; i < 9 * 1024; i += 512) { const int r = i >> 10, k = i & 1023; const float x = (r == 0) ? c.in[9][k] : c.in[8][(r - 1) * 1024 + k]; sil[i] = x / (1.f + __expf(-x)); }
    __syncthreads();
    float acc[9][2];
#pragma unroll
    for (int r = 0; r < 9; ++r) { acc[r][0] = 0.f; acc[r][1] = 0.f; }
    const float* wp = c.in[10] + ((size_t)l * 1024 + c.wave * 128) * 6144 + n0 + 2 * c.lane;
#pragma unroll 8
    for (int k = 0; k < 128; ++k) { const f32x2 w = *(const f32x2*)(wp + (size_t)k * 6144);
#pragma unroll
      for (int r = 0; r < 9; ++r) { const float s = sil[r * 1024 + c.wave * 128 + k]; acc[r][0] += s * w.x; acc[r][1] += s * w.y; } }
#pragma unroll
    for (int r = 0; r < 9; ++r) { red[(c.wave * 9 + r) * 128 + 2 * c.lane] = acc[r][0]; red[(c.wave * 9 + r) * 128 + 2 * c.lane + 1] = acc[r][1]; }
    __syncthreads();
    for (int o = c.tid; o < 9 * 128; o += 512) { const int r = o >> 7, n = o & 127; float s = c.in[11][l * 6144 + n0 + n];
#pragma unroll
      for (int w = 0; w < 8; ++w) s += red[(w * 9 + r) * 128 + n];
      MOD[(size_t)(l * 9 + r) * 6144 + n0 + n] = s; }
    __syncthreads();
  }
  { float* RC = (float*)(c.ws + WS_ROPE); float* RS = RC + 32768;
    for (int i = c.bid * 512 + c.tid; i < 2048 * 16; i += c.G * 512) { const int t = i >> 4, j = i & 15; const float pos = (float)((j < 8) ? (t >> 6) : (t & 63));
      const float inv = exp2f(-(float)(j & 7) * 0.125f * 13.287712379549449f); const float a = pos * inv;
      const float k = rintf(a * 0.15915494309189535f); float r = fmaf(-k, 6.2831854820251465f, a); r = fmaf(k, 1.7484556e-07f, r);
      RC[i] = __cosf(r); RS[i] = __sinf(r); } }
  { bf16* NC = (bf16*)(c.ws + WS_NACTX);
    for (int i = c.bid * 512 + c.tid; i < 2 * 2 * 8 * 8 * 256 * 16; i += c.G * 512) {
      const int e4 = i & 15, key = (i >> 4) & 255, h = (i >> 12) & 7, b = (i >> 15) & 7, kv = (i >> 18) & 1, ia = (i >> 19) & 1;
      const f32x4 v = *(const f32x4*)(c.in[4 + kv] + ((((size_t)b * 2 + ia) * 8 + h) * 256 + key) * 64 + 4 * e4);
      u32x2 o; o.x = pk2(v[0], v[1]); o.y = pk2(v[2], v[3]); *(u32x2*)(NC + (size_t)i * 4) = o; } }
  convert_weights(c, 0);
}

DI void row_phase(const Ctx& c, int l, int kind) {
  const float* MOD = (const float*)(c.ws + WS_MOD); const float* NG = c.in[12];
  const bf16* Y = (const bf16*)(c.ws + WS_Y); bf16* Hb = (bf16*)(c.ws + WS_H);
  const int gw = c.bid * 8 + c.wave, NGW = c.G * 8;
  const int hl = (kind == 2) ? l + 1 : l;
  const bool want_h = hl < 4;
  const float* gy = NG + (size_t)(l * 4 + (kind == 1 ? 1 : 3)) * D;
  const float* gh = NG + (size_t)((want_h ? hl : 0) * 4 + (kind == 1 ? 2 : 0)) * D;
  constexpr int RB = 3;
#define ROFF(q) (8 * (c.lane + 64 * ((q) >> 1)) + 4 * ((q) & 1))
  for (int m0 = gw; m0 < NT; m0 += RB * NGW) {
    f32x4 x[RB][4]; f32x4 y[RB][4];
#pragma unroll
    for (int k = 0; k < RB; ++k) { const int m = m0 + k * NGW; if (m < NT) {
      if (kind == 0) { const float* xi = (m < NP) ? c.in[0] + (size_t)m * D : c.in[1] + (size_t)(m - NP) * D;
#pragma unroll
        for (int q = 0; q < 4; ++q) x[k][q] = *(const f32x4*)(xi + ROFF(q));
      } else {
        const float* xs = (kind == 1 && l == 0) ? ((m < NP) ? c.in[0] + (size_t)m * D : c.in[1] + (size_t)(m - NP) * D) : c.out + (size_t)m * D;
#pragma unroll
        for (int j = 0; j < 2; ++j) { const int o = 8 * (c.lane + 64 * j);
          if (kind == 1) { const u32x4 w = *(const u32x4*)(Y + (size_t)m * D + o);
            y[k][2 * j] = (f32x4){bflo(w.x), bfhi(w.x), bflo(w.y), bfhi(w.y)}; y[k][2 * j + 1] = (f32x4){bflo(w.z), bfhi(w.z), bflo(w.w), bfhi(w.w)}; }
          else { const u32x4 w = *(const u32x4*)(Y + (size_t)m * 2 * D + o), w2 = *(const u32x4*)(Y + (size_t)m * 2 * D + D + o);
            y[k][2 * j] = (f32x4){bflo(w.x) + bflo(w2.x), bfhi(w.x) + bfhi(w2.x), bflo(w.y) + bflo(w2.y), bfhi(w.y) + bfhi(w2.y)};
            y[k][2 * j + 1] = (f32x4){bflo(w.z) + bflo(w2.z), bfhi(w.z) + bfhi(w2.z), bflo(w.w) + bflo(w2.w), bfhi(w.w) + bfhi(w2.w)}; }
          x[k][2 * j] = *(const f32x4*)(xs + o); x[k][2 * j + 1] = *(const f32x4*)(xs + o + 4); }
      } } }
#pragma unroll
    for (int k = 0; k < RB; ++k) { const int m = m0 + k * NGW; if (m < NT) {
      const int r = (m < NP) ? 0 : 1 + ((m - NP) >> 11);
      float* xo = c.out + (size_t)m * D;
      if (kind != 0) {
        const float* gate = MOD + ((size_t)(l * 9 + r) * 6 + (kind == 1 ? 2 : 5)) * D;
        float ss = 0.f;
#pragma unroll
        for (int q = 0; q < 4; ++q) ss += y[k][q][0] * y[k][q][0] + y[k][q][1] * y[k][q][1] + y[k][q][2] * y[k][q][2] + y[k][q][3] * y[k][q][3];
        const float rs = 1.0f / sqrtf(wave_sum(ss) * (1.f / D) + EPS);
#pragma unroll
        for (int q = 0; q < 4; ++q) { const f32x4 g = *(const f32x4*)(gy + ROFF(q)); const f32x4 gt = *(const f32x4*)(gate + ROFF(q));
          x[k][q] = x[k][q] + gt * (y[k][q] * rs * g); }
#pragma unroll
        for (int q = 0; q < 4; ++q) *(f32x4*)(xo + ROFF(q)) = x[k][q];
      }
      if (want_h) {
        const float* shift = MOD + ((size_t)(hl * 9 + r) * 6 + (kind == 1 ? 3 : 0)) * D; const float* scale = shift + D;
        float ss = 0.f;
#pragma unroll
        for (int q = 0; q < 4; ++q) ss += x[k][q][0] * x[k][q][0] + x[k][q][1] * x[k][q][1] + x[k][q][2] * x[k][q][2] + x[k][q][3] * x[k][q][3];
        const float rs = 1.0f / sqrtf(wave_sum(ss) * (1.f / D) + EPS);
#pragma unroll
        for (int j = 0; j < 2; ++j) { u32x4 w;
#pragma unroll
          for (int hf = 0; hf < 2; ++hf) { const int q = 2 * j + hf, o = ROFF(q); const f32x4 g = *(const f32x4*)(gh + o); const f32x4 sh = *(const f32x4*)(shift + o); const f32x4 sc = *(const f32x4*)(scale + o);
            const f32x4 hv = (x[k][q] * rs * g) * (sc + 1.0f) + sh;
            if (hf == 0) { w.x = pk2(hv[0], hv[1]); w.y = pk2(hv[2], hv[3]); } else { w.z = pk2(hv[0], hv[1]); w.w = pk2(hv[2], hv[3]); } }
          *(u32x4*)(Hb + (size_t)m * D + 8 * (c.lane + 64 * j)) = w; }
      } } }
  }
#undef ROFF
}

DI void mla_rows(const Ctx& c, int ic) {
  const float* Cb = (const float*)(c.ws + WS_BIG); bf16* CQ = (bf16*)(c.ws + WS_H); bf16* CKV = (bf16*)(c.ws + WS_H + H_CKVN); bf16* KPE = (bf16*)(c.ws + WS_KPE);
  const float* RC = (const float*)(c.ws + WS_ROPE); const float* RS = RC + 32768;
  const float* qn = c.in[21] + ic * 384; const float* kvn = c.in[22] + ic * 256;
  const int gw = c.bid * 8 + c.wave, NGW = c.G * 8;
  constexpr int RB = 3;
  const bool ql = c.lane < 48;
  for (int m0 = gw; m0 < NT; m0 += RB * NGW) {
    f32x4 qa[RB], qb[RB], kv[RB]; float xk[RB];
#pragma unroll
    for (int k = 0; k < RB; ++k) { const int m = m0 + k * NGW; if (m < NT) { const float* cr = Cb + (size_t)m * CINP;
      qa[k] = ql ? *(const f32x4*)(cr + 8 * c.lane) : (f32x4){0.f, 0.f, 0.f, 0.f}; qb[k] = ql ? *(const f32x4*)(cr + 8 * c.lane + 4) : (f32x4){0.f, 0.f, 0.f, 0.f};
      kv[k] = *(const f32x4*)(cr + 384 + 4 * c.lane); xk[k] = cr[640 + (c.lane & 31)]; } }
#pragma unroll
    for (int k = 0; k < RB; ++k) { const int m = m0 + k * NGW; if (m < NT) {
      float ss = qa[k][0] * qa[k][0] + qa[k][1] * qa[k][1] + qa[k][2] * qa[k][2] + qa[k][3] * qa[k][3] + qb[k][0] * qb[k][0] + qb[k][1] * qb[k][1] + qb[k][2] * qb[k][2] + qb[k][3] * qb[k][3];
      float rs = 1.0f / sqrtf(wave_sum(ss) * (1.f / 384.f) + EPS);
      if (ql) { const f32x4 g0 = *(const f32x4*)(qn + 8 * c.lane), g1 = *(const f32x4*)(qn + 8 * c.lane + 4); const f32x4 a = qa[k] * rs * g0, b = qb[k] * rs * g1;
        u32x4 w; w.x = pk2(a[0], a[1]); w.y = pk2(a[2], a[3]); w.z = pk2(b[0], b[1]); w.w = pk2(b[2], b[3]); *(u32x4*)(CQ + (size_t)m * 384 + 8 * c.lane) = w; }
      ss = kv[k][0] * kv[k][0] + kv[k][1] * kv[k][1] + kv[k][2] * kv[k][2] + kv[k][3] * kv[k][3];
      rs = 1.0f / sqrtf(wave_sum(ss) * (1.f / 256.f) + EPS);
      const f32x4 kn = kv[k] * rs * *(const f32x4*)(kvn + 4 * c.lane);
      u32x2 w; w.x = pk2(kn[0], kn[1]); w.y = pk2(kn[2], kn[3]); *(u32x2*)(CKV + (size_t)m * 256 + 4 * c.lane) = w;
      const float pk = __shfl_xor(xk[k], 1);
      if (m < NP) { const int b = m >> 8, s = m & 255; const size_t slot = ((size_t)(b * 2 + ic) * 256 + s);
        *(f32x4*)(c.out + O_CKV + slot * 256 + 4 * c.lane) = kn;
        if (c.lane < 32) { c.out[O_KPE + slot * 32 + c.lane] = xk[k]; KPE[(size_t)m * 32 + c.lane] = f2bf(xk[k]); }
      } else { const int pos = (m - NP) & 2047; const int pi = (c.lane & 31) >> 1; const float cs = RC[pos * 16 + pi], sn = RS[pos * 16 + pi];
        const float val = (c.lane & 1) ? (pk * sn + xk[k] * cs) : (xk[k] * cs - pk * sn);
        if (c.lane < 32) KPE[(size_t)m * 32 + c.lane] = f2bf(val); }
    } }
  }
  for (int m = NT + gw; m < NT + NCTX; m += NGW) {
    const int cr = m - NT, b = cr >> 8, s = cr & 255; const size_t slot = ((size_t)(b * 2 + ic) * 256 + s);
    const f32x4 kv = *(const f32x4*)(c.in[6] + slot * 256 + 4 * c.lane);
    u32x2 w; w.x = pk2(kv[0], kv[1]); w.y = pk2(kv[2], kv[3]); *(u32x2*)(CKV + (size_t)m * 256 + 4 * c.lane) = w;
    if (c.lane < 32) KPE[(size_t)m * 32 + c.lane] = f2bf(c.in[7][slot * 32 + c.lane]);
  }
}

DI void ret_kv_item(const Ctx& c, int item, int ia) {
  const int p = item >> 3, h = item & 7;
  const bf16* Pb = (const bf16*)(c.ws + WS_BIG);
  float* KVF = (float*)(c.ws + WS_Y); float* KVB = (float*)(c.ws + WS_Y + Y_KVB);
  const float lgf2 = log_decay2(c.in[17][ia * 8 + h]), lgb2 = log_decay2(c.in[18][ia * 8 + h]);
  LAS bf16* Kn = (LAS bf16*)c.lds; LAS bf16* VF = (LAS bf16*)(c.lds + 36864); LAS bf16* VB = (LAS bf16*)(c.lds + 73728);
#pragma unroll
  for (int it = 0; it < 4; ++it) { const int q = c.tid + 512 * it, tok = q >> 3, part = q & 7;
    const bf16* rowp = Pb + (size_t)(256 * p + tok) * ACIN + h * 64 + part * 8;
    const u32x4 kk = *(const u32x4*)(rowp + 512); const u32x4 vv = *(const u32x4*)(rowp + 1024);
    const int i = tok & 127; const float df = exp2f(lgf2 * (float)(127 - i)), db = exp2f(lgb2 * (float)i);
    u32x4 vf, vb;
#pragma unroll
    for (int j = 0; j < 4; ++j) { const float v0 = bflo(vv[j]), v1 = bfhi(vv[j]); vf[j] = pk2(v0 * df, v1 * df); vb[j] = pk2(v0 * db, v1 * db); }
    *(LAS u32x4*)(Kn + tok * 72 + part * 8) = kk; *(LAS u32x4*)(VF + tok * 72 + part * 8) = vf; *(LAS u32x4*)(VB + tok * 72 + part * 8) = vb; }
  __syncthreads();
  { const int cw = c.wave >> 2, dir = (c.wave >> 1) & 1, eb = c.wave & 1, r = c.lane & 31, hh = c.lane >> 5;
    const int tq = (c.lane & 15) >> 2, tp = c.lane & 3, tblk = (c.lane >> 4) & 1;
    const LAS bf16* Vd = dir ? VB : VF;
    f32x16 a0 = zero16(), a1 = zero16();
#pragma unroll
    for (int ks = 0; ks < 8; ++ks) { const int row = cw * 128 + 16 * ks + 8 * hh + tq, col = 16 * tblk + 4 * tp;
      const bf16x8 A = cat8(tr_read(Vd + row * 72 + eb * 32 + col), tr_read(Vd + (row + 4) * 72 + eb * 32 + col));
      const bf16x8 B0 = cat8(tr_read(Kn + row * 72 + col), tr_read(Kn + (row + 4) * 72 + col));
      const bf16x8 B1 = cat8(tr_read(Kn + row * 72 + 32 + col), tr_read(Kn + (row + 4) * 72 + 32 + col));
      a0 = MFMA32(A, B0, a0); a1 = MFMA32(A, B1, a1); }
    float* dst = (dir ? KVB : KVF) + ((size_t)((2 * p + cw) * 8 + h) * 64) * 64;
#pragma unroll
    for (int reg = 0; reg < 16; ++reg) { const int e = eb * 32 + crow(reg, hh); dst[e * 64 + r] = a0[reg]; dst[e * 64 + 32 + r] = a1[reg]; } }
  __syncthreads();
}

DI void ret_out_item(const Ctx& c, int item, int ia) {
  const int p = item >> 3, h = item & 7;
  const bf16* Pb = (const bf16*)(c.ws + WS_BIG); bf16* AO = (bf16*)(c.ws + WS_H);
  const float* KVF = (const float*)(c.ws + WS_Y); const float* KVB = (const float*)(c.ws + WS_Y + Y_KVB);
  const float lgf2 = log_decay2(c.in[17][ia * 8 + h]), lgb2 = log_decay2(c.in[18][ia * 8 + h]);
  LAS bf16* Ks = (LAS bf16*)c.lds; LAS bf16* Vs = (LAS bf16*)(c.lds + 36864); LAS bf16* St = (LAS bf16*)(c.lds + 73728);
#pragma unroll
  for (int it = 0; it < 4; ++it) { const int q = c.tid + 512 * it, tok = q >> 3, part = q & 7;
    const bf16* rowp = Pb + (size_t)(256 * p + tok) * ACIN + h * 64 + part * 8;
    const u32x4 kk = *(const u32x4*)(rowp + 512); const u32x4 vv = *(const u32x4*)(rowp + 1024);
    *(LAS u32x4*)(Ks + tok * 72 + part * 8) = kk; *(LAS u32x4*)(Vs + tok * 72 + part * 8) = vv; }
  { const bool lat = p >= 32; const int b = lat ? ((p - 32) >> 3) : p; const int n0 = lat ? 2 * ((p - 32) & 7) : 0; const int N = lat ? 16 : 2; const int cbase = lat ? 64 + b * 16 : 2 * p;
    const int e = c.tid >> 3, d0 = (c.tid & 7) * 8;
    const float Gf = exp2f(lgf2 * 128.f), Gb = exp2f(lgb2 * 128.f);
    const size_t eo = (size_t)e * 64 + d0;
    float sf[8], sb[8];
    if (lat) { const float* s0f = c.in[2] + ((size_t)((b * 2 + ia) * 8 + h) * 64) * 64; const float* s0b = c.in[3] + ((size_t)((b * 2 + ia) * 8 + h) * 64) * 64;
#pragma unroll
      for (int j = 0; j < 8; ++j) { sf[j] = s0f[(d0 + j) * 64 + e]; sb[j] = s0b[(d0 + j) * 64 + e]; }
    } else {
#pragma unroll
      for (int j = 0; j < 8; ++j) { sf[j] = 0.f; sb[j] = 0.f; } }
    for (int j0 = 0; j0 < n0; j0 += 4) {
      f32x4 a[4], bq[4];
#pragma unroll
      for (int u = 0; u < 4; ++u) { const int j = min(j0 + u, n0 - 1); const float* kv = KVF + ((size_t)((cbase + j) * 8 + h) * 4096) + eo; a[u] = *(const f32x4*)kv; bq[u] = *(const f32x4*)(kv + 4); }
#pragma unroll
      for (int u = 0; u < 4; ++u) if (j0 + u < n0) {
#pragma unroll
        for (int q = 0; q < 4; ++q) { sf[q] = Gf * sf[q] + a[u][q]; sf[4 + q] = Gf * sf[4 + q] + bq[u][q]; } } }
    for (int j0 = N - 1; j0 >= n0 + 2; j0 -= 4) {
      f32x4 a[4], bq[4];
#pragma unroll
      for (int u = 0; u < 4; ++u) { const int j = max(j0 - u, n0 + 2); const float* kv = KVB + ((size_t)((cbase + j) * 8 + h) * 4096) + eo; a[u] = *(const f32x4*)kv; bq[u] = *(const f32x4*)(kv + 4); }
#pragma unroll
      for (int u = 0; u < 4; ++u) if (j0 - u >= n0 + 2) {
#pragma unroll
        for (int q = 0; q < 4; ++q) { sb[q] = Gb * sb[q] + a[u][q]; sb[4 + q] = Gb * sb[4 + q] + bq[u][q]; } } }
    { u32x4 w; w.x = pk2(sf[0], sf[1]); w.y = pk2(sf[2], sf[3]); w.z = pk2(sf[4], sf[5]); w.w = pk2(sf[6], sf[7]); *(LAS u32x4*)(St + 0 * 4608 + e * 72 + d0) = w; }
    { u32x4 w; w.x = pk2(sb[0], sb[1]); w.y = pk2(sb[2], sb[3]); w.z = pk2(sb[4], sb[5]); w.w = pk2(sb[6], sb[7]); *(LAS u32x4*)(St + 3 * 4608 + e * 72 + d0) = w; }
    { const float* kv = KVF + ((size_t)((cbase + n0) * 8 + h) * 4096) + eo; const f32x4 a = *(const f32x4*)kv, bq = *(const f32x4*)(kv + 4);
#pragma unroll
      for (int q = 0; q < 4; ++q) { sf[q] = Gf * sf[q] + a[q]; sf[4 + q] = Gf * sf[4 + q] + bq[q]; } }
    { const float* kv = KVB + ((size_t)((cbase + n0 + 1) * 8 + h) * 4096) + eo; const f32x4 a = *(const f32x4*)kv, bq = *(const f32x4*)(kv + 4);
#pragma unroll
      for (int q = 0; q < 4; ++q) { sb[q] = Gb * sb[q] + a[q]; sb[4 + q] = Gb * sb[4 + q] + bq[q]; } }
    { u32x4 w; w.x = pk2(sf[0], sf[1]); w.y = pk2(sf[2], sf[3]); w.z = pk2(sf[4], sf[5]); w.w = pk2(sf[6], sf[7]); *(LAS u32x4*)(St + 1 * 4608 + e * 72 + d0) = w; }
    { u32x4 w; w.x = pk2(sb[0], sb[1]); w.y = pk2(sb[2], sb[3]); w.z = pk2(sb[4], sb[5]); w.w = pk2(sb[6], sb[7]); *(LAS u32x4*)(St + 2 * 4608 + e * 72 + d0) = w; }
    if (!lat) {
      const float* kv1 = KVF + ((size_t)((cbase + 1) * 8 + h) * 4096) + eo; const float* kv0 = KVB + ((size_t)((cbase + 0) * 8 + h) * 4096) + eo;
      float* of = c.out + O_RF + ((size_t)((b * 2 + ia) * 8 + h) * 64) * 64; float* ob = c.out + O_RB + ((size_t)((b * 2 + ia) * 8 + h) * 64) * 64;
#pragma unroll
      for (int j = 0; j < 8; ++j) { of[(d0 + j) * 64 + e] = Gf * sf[j] + kv1[j]; ob[(d0 + j) * 64 + e] = Gb * sb[j] + kv0[j]; } }
  }
  __syncthreads();
  { const int cw = c.wave >> 2, r = c.lane & 31, hh = c.lane >> 5; const int iloc = 32 * (c.wave & 3) + r; const int m = 256 * p + 128 * cw + iloc;
    bf16x8 Qf[4];
#pragma unroll
    for (int ks = 0; ks < 4; ++ks) Qf[ks] = *(const bf16x8*)(Pb + (size_t)m * ACIN + h * 64 + 16 * ks + 8 * hh);
    if (c.wave >= 4) __builtin_amdgcn_s_setprio(1);
    f32x16 O0, O1;
    { const float decf = exp2f(lgf2 * (float)(iloc + 1)), decb = exp2f(lgb2 * (float)(128 - iloc));
      f32x16 f0 = zero16(), f1 = zero16();
      LAS bf16* SF = St + cw * 4608; LAS bf16* SB = St + (2 + cw) * 4608;
#pragma unroll
      for (int ks = 0; ks < 4; ++ks) { const int ko = 16 * ks + 8 * hh;
        f0 = MFMA32(*(const LAS bf16x8*)(SF + r * 72 + ko), Qf[ks], f0); f1 = MFMA32(*(const LAS bf16x8*)(SF + (32 + r) * 72 + ko), Qf[ks], f1); }
#pragma unroll
      for (int reg = 0; reg < 16; ++reg) { O0[reg] = decf * f0[reg]; O1[reg] = decf * f1[reg]; }
      f0 = zero16(); f1 = zero16();
#pragma unroll
      for (int ks = 0; ks < 4; ++ks) { const int ko = 16 * ks + 8 * hh;
        f0 = MFMA32(*(const LAS bf16x8*)(SB + r * 72 + ko), Qf[ks], f0); f1 = MFMA32(*(const LAS bf16x8*)(SB + (32 + r) * 72 + ko), Qf[ks], f1); }
#pragma unroll
      for (int reg = 0; reg < 16; ++reg) { O0[reg] += decb * f0[reg]; O1[reg] += decb * f1[reg]; } }
#pragma unroll 1
    for (int kb = 0; kb < 4; ++kb) {
      f32x16 s = zero16();
#pragma unroll
      for (int ks = 0; ks < 4; ++ks) { const bf16x8 A = *(const LAS bf16x8*)(Ks + (128 * cw + 32 * kb + r) * 72 + 16 * ks + 8 * hh); s = MFMA32(A, Qf[ks], s); }
#pragma unroll
      for (int reg = 0; reg < 16; ++reg) { const int diff = iloc - (32 * kb + crow(reg, hh));
        const float ex = __builtin_amdgcn_exp2f((diff > 0 ? lgf2 : -lgb2) * (float)diff);
        s[reg] *= (diff == 0) ? 2.0f : ex; }
#pragma unroll
      for (int sp = 0; sp < 2; ++sp) {
        u32x4 pw; pw.x = pk2(s[8 * sp + 0], s[8 * sp + 1]); pw.y = pk2(s[8 * sp + 2], s[8 * sp + 3]); pw.z = pk2(s[8 * sp + 4], s[8 * sp + 5]); pw.w = pk2(s[8 * sp + 6], s[8 * sp + 7]);
        const bf16x8 Pf = __builtin_bit_cast(bf16x8, pw);
        const int vrow = 128 * cw + 32 * kb + 16 * sp + 4 * hh + ((c.lane & 15) >> 2), vcol = 16 * ((c.lane >> 4) & 1) + 4 * (c.lane & 3);
        O0 = MFMA32(cat8(tr_read(Vs + vrow * 72 + vcol), tr_read(Vs + (vrow + 8) * 72 + vcol)), Pf, O0);
        O1 = MFMA32(cat8(tr_read(Vs + vrow * 72 + 32 + vcol), tr_read(Vs + (vrow + 8) * 72 + 32 + vcol)), Pf, O1);
      }
    }
    float sm = 0.f;
#pragma unroll
    for (int reg = 0; reg < 16; ++reg) sm += O0[reg] + O1[reg];
    sm += __shfl_xor(sm, 32); const float mu = sm * (1.f / 64.f);
    float vs = 0.f;
#pragma unroll
    for (int reg = 0; reg < 16; ++reg) { const float a = O0[reg] - mu, bq = O1[reg] - mu; vs += a * a + bq * bq; }
    vs += __shfl_xor(vs, 32); const float rs = 1.0f / sqrtf(vs * (1.f / 64.f) + EPS);
    const bf16* gp = Pb + (size_t)m * ACIN + 1536 + h * 64; bf16* op = AO + (size_t)m * D + h * 64;
#pragma unroll
    for (int eb = 0; eb < 2; ++eb)
#pragma unroll
      for (int g = 0; g < 4; ++g) { const int e = eb * 32 + 8 * g + 4 * hh; const u32x2 gw = *(const u32x2*)(gp + e);
        float gv[4] = {bflo(gw.x), bfhi(gw.x), bflo(gw.y), bfhi(gw.y)}; float ov[4];
#pragma unroll
        for (int j = 0; j < 4; ++j) { const float o = ((eb ? O1[4 * g + j] : O0[4 * g + j]) - mu) * rs; const float gg = gv[j]; ov[j] = o * (gg * __builtin_amdgcn_rcpf(1.f + __expf(-gg))); }
        u32x2 w; w.x = pk2(ov[0], ov[1]); w.y = pk2(ov[2], ov[3]); *(u32x2*)(op + e) = w; }
  }
  __builtin_amdgcn_s_setprio(0);
  __syncthreads();
}

template <int MODE> DI void attn_item(const Ctx& c, int item, int hl) {
  constexpr int DQK = (MODE >= 2) ? 96 : 64, KS = DQK / 16, KLD = DQK + 8, VLD = 72, BUFB = 24576, VOFF = 13312;
  const int r = c.lane & 31, hh = c.lane >> 5, w = c.wave;
  const bf16* Pb = (const bf16*)(c.ws + WS_BIG);
  const bf16* KVb = (const bf16*)(c.ws + WS_BIG + BIG_KV);
  const bf16* KPE = (const bf16*)(c.ws + WS_KPE);
  const bf16* NC = (const bf16*)(c.ws + WS_NACTX);
  bf16* AO = (bf16*)(c.ws + WS_H);
  int b, h, g = 0, m, nt, nloc = 0, Rlo = 0, qr = 0, qc = 0, wsr = 0, wsc = 0;
  if (MODE == 0) { b = item >> 3; h = item & 7; m = b * 256 + 32 * w + r; nt = 4; }
  else if (MODE == 1) { b = item >> 6; h = (item >> 3) & 7; g = item & 7; qr = 4 * g + (w >> 1); qc = 32 * (w & 1) + r; m = NP + b * 2048 + qr * 64 + qc;
    Rlo = max(4 * g - 4, 0); Rlo = min(Rlo, 24); const int Rhi = min(max(4 * g - 1, 0), 24) + 7; nloc = Rhi - Rlo + 1; nt = nloc + 4;
    wsr = min(max(qr - 4, 0), 24); wsc = min(max(qc - 8, 0), 48); }
  else if (MODE == 2) { b = item >> 4; h = item & 15; m = b * 256 + 32 * w + r; nt = 4; }
  else { b = item >> 7; h = (item >> 3) & 15; g = item & 7; m = NP + b * 2048 + g * 256 + 32 * w + r; nt = 36; }
  const float sc2 = ((MODE >= 2) ? 0.10206207261596577f : 0.125f) * LOG2E;
  LAS float* rpbs = (LAS float*)(c.lds + 49152);
  if (MODE == 1) { for (int i = c.tid; i < 465; i += 512) rpbs[i] = c.in[19][(size_t)(hl * 8 + h) * 465 + i] * LOG2E; }
  bf16x8 Qf[KS]; bf16x8 Qr[2];
  if (MODE < 2) {
#pragma unroll
    for (int ks = 0; ks < KS; ++ks) Qf[ks] = *(const bf16x8*)(Pb + (size_t)m * ACIN + 2048 + h * 64 + 16 * ks + 8 * hh);
  } else {
#pragma unroll
    for (int ks = 0; ks < KS; ++ks) Qf[ks] = *(const bf16x8*)(Pb + (size_t)m * 1536 + h * 96 + 16 * ks + 8 * hh);
  }
  if (MODE == 3) { const float* RC = (const float*)(c.ws + WS_ROPE); const float* RS = RC + 32768; const int pos = g * 256 + 32 * w + r;
#pragma unroll
    for (int k2 = 0; k2 < 2; ++k2) { const f32x4 cs = *(const f32x4*)(RC + pos * 16 + 8 * k2 + 4 * hh), sn = *(const f32x4*)(RS + pos * 16 + 8 * k2 + 4 * hh);
      const u32x4 xw = __builtin_bit_cast(u32x4, Qf[4 + k2]); u32x4 ow;
#pragma unroll
      for (int q = 0; q < 4; ++q) { const float x1 = bflo(xw[q]), x2 = bfhi(xw[q]); ow[q] = pk2(x1 * cs[q] - x2 * sn[q], x1 * sn[q] + x2 * cs[q]); }
      Qr[k2] = __builtin_bit_cast(bf16x8, ow); } }
  const int skey = c.tid >> 3, spart = c.tid & 7, pkey = c.tid >> 2, ppart = c.tid & 3;
  u32x4 kreg = {0u,0u,0u,0u}, vreg = {0u,0u,0u,0u}, preg = {0u,0u,0u,0u};
#define TILE_ROW(t) ((MODE == 0 || MODE == 2) ? (b * 256 + 64 * (t)) : (MODE == 1) ? (NP + b * 2048 + (Rlo + (t)) * 64) : (((t) < 32) ? NP + b * 2048 + 64 * (t) : NT + b * 256 + 64 * ((t) - 32)))
#define LOAD_TILE(t) do { \
    if (MODE == 0 || (MODE == 1 && (t) < nloc)) { const bf16* rp_ = Pb + (size_t)(TILE_ROW(t) + skey) * ACIN + h * 64 + spart * 8; kreg = *(const u32x4*)(rp_ + 2560); vreg = *(const u32x4*)(rp_ + 3072); } \
    else if (MODE == 1) { const int tc_ = (t) - nloc; const size_t base_ = ((size_t)((hl * 2 + 0) * 8 + b) * 8 + h) * 16384 + (size_t)(64 * tc_ + skey) * 64 + spart * 8; \
      kreg = *(const u32x4*)(NC + base_); vreg = *(const u32x4*)(NC + base_ + (size_t)8 * 8 * 16384); } \
    else { const int row_ = TILE_ROW(t); const bf16* rp_ = KVb + (size_t)(row_ + skey) * 2048 + h * 64 + spart * 8; kreg = *(const u32x4*)rp_; vreg = *(const u32x4*)(rp_ + 1024); \
      if (c.tid < 256) preg = *(const u32x4*)(KPE + (size_t)(row_ + pkey) * 32 + ppart * 8); } } while (0)
#define STORE_TILE(bufi) do { \
    LAS bf16* Ks_ = (LAS bf16*)(c.lds + (bufi) * BUFB); LAS bf16* Vt_ = (LAS bf16*)(c.lds + (bufi) * BUFB + VOFF); \
    *(LAS u32x4*)(Ks_ + skey * KLD + spart * 8) = kreg; \
    if (MODE >= 2) { if (c.tid < 256) *(LAS u32x4*)(Ks_ + pkey * KLD + 64 + ppart * 8) = preg; } \
    *(LAS u32x4*)(Vt_ + skey * VLD + spart * 8) = vreg; } while (0)
  f32x16 O0 = zero16(), O1 = zero16(), Ls = zero16();
  const bf16x8 ones8 = {(short)0x3f80, (short)0x3f80, (short)0x3f80, (short)0x3f80, (short)0x3f80, (short)0x3f80, (short)0x3f80, (short)0x3f80};
  float mrun = -1e30f;
  LOAD_TILE(0); STORE_TILE(0);
  __syncthreads();
  if (w >= 4) __builtin_amdgcn_s_setprio(1);
  for (int t = 0; t < nt; ++t) {
    if (t + 1 < nt) LOAD_TILE(t + 1);
    bool active = true; int R = 0;
    if (MODE == 1 && t < nloc) { R = Rlo + t; active = (R >= wsr) && (R < wsr + 8); }
    if (active) {
      LAS bf16* Ks = (LAS bf16*)(c.lds + (t & 1) * BUFB); LAS bf16* Vt = (LAS bf16*)(c.lds + (t & 1) * BUFB + VOFF);
      f32x16 s0 = zero16(), s1 = zero16();
      const bool rot = (MODE == 3) && (t < 32);
#pragma unroll
      for (int ks = 0; ks < KS; ++ks) { bf16x8 q = Qf[ks]; if (MODE == 3 && ks >= 4) q = rot ? Qr[ks - 4] : Qf[ks];
        const bf16x8 A0 = *(const LAS bf16x8*)(Ks + r * KLD + 16 * ks + 8 * hh); const bf16x8 A1 = *(const LAS bf16x8*)(Ks + (32 + r) * KLD + 16 * ks + 8 * hh);
        s0 = MFMA32(A0, q, s0); s1 = MFMA32(A1, q, s1); }
      float tmax = -1e30f, mnew, alpha;
      if (MODE == 1 && t < nloc) {
        const int dro = (R - qr + 7) * 31;
#pragma unroll
        for (int reg = 0; reg < 16; ++reg) { const int k0 = crow(reg, hh) - wsc, k1 = k0 + 32;
          const bool v0 = (unsigned)k0 < 16u, v1 = (unsigned)k1 < 16u;
          const int bo = dro + wsc - qc + 15;
          const float b0 = rpbs[v0 ? bo + k0 : 0], b1 = rpbs[v1 ? bo + k1 : 0];
          s0[reg] = v0 ? fmaf(s0[reg], sc2, b0) : -1e30f; s1[reg] = v1 ? fmaf(s1[reg], sc2, b1) : -1e30f;
          tmax = fmax_nc(tmax, s0[reg]); tmax = fmax_nc(tmax, s1[reg]); }
        tmax = fmaxf(tmax, __shfl_xor(tmax, 32));
        mnew = fmaxf(mrun, tmax); alpha = __builtin_amdgcn_exp2f(mrun - mnew); mrun = mnew;
#pragma unroll
        for (int reg = 0; reg < 16; ++reg) { s0[reg] = __builtin_amdgcn_exp2f(s0[reg] - mnew); s1[reg] = __builtin_amdgcn_exp2f(s1[reg] - mnew); }
      } else {
#pragma unroll
        for (int reg = 0; reg < 16; ++reg) { tmax = fmax_nc(tmax, s0[reg]); tmax = fmax_nc(tmax, s1[reg]); }
        tmax = fmaxf(tmax, __shfl_xor(tmax, 32));
        mnew = fmaxf(mrun, tmax * sc2); alpha = __builtin_amdgcn_exp2f(mrun - mnew); mrun = mnew;
#pragma unroll
        for (int reg = 0; reg < 16; ++reg) { s0[reg] = __builtin_amdgcn_exp2f(fmaf(s0[reg], sc2, -mnew)); s1[reg] = __builtin_amdgcn_exp2f(fmaf(s1[reg], sc2, -mnew)); }
      }
#pragma unroll
      for (int reg = 0; reg < 16; ++reg) { O0[reg] *= alpha; O1[reg] *= alpha; Ls[reg] *= alpha; }
#pragma unroll
      for (int kb = 0; kb < 2; ++kb)
#pragma unroll
        for (int sp = 0; sp < 2; ++sp) {
          u32x4 pw;
          if (kb == 0) { pw.x = pk2(s0[8 * sp + 0], s0[8 * sp + 1]); pw.y = pk2(s0[8 * sp + 2], s0[8 * sp + 3]); pw.z = pk2(s0[8 * sp + 4], s0[8 * sp + 5]); pw.w = pk2(s0[8 * sp + 6], s0[8 * sp + 7]); }
          else { pw.x = pk2(s1[8 * sp + 0], s1[8 * sp + 1]); pw.y = pk2(s1[8 * sp + 2], s1[8 * sp + 3]); pw.z = pk2(s1[8 * sp + 4], s1[8 * sp + 5]); pw.w = pk2(s1[8 * sp + 6], s1[8 * sp + 7]); }
          const bf16x8 Pf = __builtin_bit_cast(bf16x8, pw);
          const int vrow = 32 * kb + 16 * sp + 4 * hh + ((c.lane & 15) >> 2), vcol = 16 * ((c.lane >> 4) & 1) + 4 * (c.lane & 3);
          Ls = MFMA32(ones8, Pf, Ls);
          O0 = MFMA32(cat8(tr_read(Vt + vrow * VLD + vcol), tr_read(Vt + (vrow + 8) * VLD + vcol)), Pf, O0);
          O1 = MFMA32(cat8(tr_read(Vt + vrow * VLD + 32 + vcol), tr_read(Vt + (vrow + 8) * VLD + 32 + vcol)), Pf, O1);
        }
    }
    if (t + 1 < nt) STORE_TILE((t + 1) & 1);
    __syncthreads();
  }
  __builtin_amdgcn_s_setprio(0);
  { const float inv = 1.0f / Ls[0];
    bf16* op = AO + (size_t)m * D + ((MODE < 2) ? 512 : 0) + h * 64;
#pragma unroll
    for (int eb = 0; eb < 2; ++eb)
#pragma unroll
      for (int gq = 0; gq < 4; ++gq) { const int e = eb * 32 + 8 * gq + 4 * hh;
        u32x2 wv; if (eb == 0) { wv.x = pk2(O0[4 * gq] * inv, O0[4 * gq + 1] * inv); wv.y = pk2(O0[4 * gq + 2] * inv, O0[4 * gq + 3] * inv); }
        else { wv.x = pk2(O1[4 * gq] * inv, O1[4 * gq + 1] * inv); wv.y = pk2(O1[4 * gq + 2] * inv, O1[4 * gq + 3] * inv); }
        *(u32x2*)(op + e) = wv; } }
  __syncthreads();
}

template <int LAT> DI void mla_item(const Ctx& c, int item) {
  constexpr int KS = 6, KLD = 104, VLD = 72, KBS = 13312, VB0 = 26624, VBS = 9216;
  const int r = c.lane & 31, hh = c.lane >> 5, w = c.wave;
  const bf16* Qb = (const bf16*)(c.ws + WS_BIG); const bf16* KVb = (const bf16*)(c.ws + WS_BIG + BIG_KV); const bf16* KPE = (const bf16*)(c.ws + WS_KPE);
  bf16* AO = (bf16*)(c.ws + WS_H);
  int b, h, g = 0, m, nt;
  if (!LAT) { b = item >> 4; h = item & 15; m = b * 256 + 32 * w + r; nt = 4; }
  else { b = item >> 7; h = (item >> 3) & 15; g = item & 7; m = NP + b * 2048 + g * 256 + 32 * w + r; nt = 36; }
  const float sc2 = 0.10206207261596577f * LOG2E;
  bf16x8 Qf[4]; bf16x8 Qp[2];
  const bf16* qrow = Qb + (size_t)m * 1536 + h * 96 + 8 * hh;
#pragma unroll
  for (int ks = 0; ks < 4; ++ks) Qf[ks] = *(const bf16x8*)(qrow + 16 * ks);
#pragma unroll
  for (int k2 = 0; k2 < 2; ++k2) Qp[k2] = *(const bf16x8*)(qrow + 64 + 16 * k2);
  if (LAT) { const float* RC = (const float*)(c.ws + WS_ROPE); const float* RS = RC + 32768; const int pos = g * 256 + 32 * w + r;
#pragma unroll
    for (int k2 = 0; k2 < 2; ++k2) { const f32x4 cs = *(const f32x4*)(RC + pos * 16 + 8 * k2 + 4 * hh), sn = *(const f32x4*)(RS + pos * 16 + 8 * k2 + 4 * hh);
      const u32x4 xw = __builtin_bit_cast(u32x4, Qp[k2]); u32x4 ow;
#pragma unroll
      for (int q = 0; q < 4; ++q) { const float x1 = bflo(xw[q]), x2 = bfhi(xw[q]); ow[q] = pk2(x1 * cs[q] - x2 * sn[q], x1 * sn[q] + x2 * cs[q]); }
      Qp[k2] = __builtin_bit_cast(bf16x8, ow); } }
  const int skey = c.tid >> 3, spart = c.tid & 7, pkey = (c.tid >> 2) & 63, ppart = c.tid & 3;
  const int vq = (c.lane & 15) >> 2, vcol = 16 * ((c.lane >> 4) & 1) + 4 * (c.lane & 3);
  u32x4 kregA = {0u, 0u, 0u, 0u}, vregA = {0u, 0u, 0u, 0u}, pregA = {0u, 0u, 0u, 0u}, kregB = {0u, 0u, 0u, 0u}, vregB = {0u, 0u, 0u, 0u}, pregB = {0u, 0u, 0u, 0u};
#define MROW(t) (LAT ? (((t) < 32) ? NP + b * 2048 + 64 * (t) : NT + b * 256 + 64 * ((t) - 32)) : b * 256 + 64 * (t))
#define LOADK(S, t) do { const int row_ = MROW(t); kreg##S = *(const u32x4*)(KVb + (size_t)(row_ + skey) * 2048 + h * 64 + spart * 8); if (c.tid < 256) preg##S = *(const u32x4*)(KPE + (size_t)(row_ + pkey) * 32 + ppart * 8); } while (0)
#define LOADV(S, t) do { const int row_ = MROW(t); vreg##S = *(const u32x4*)(KVb + (size_t)(row_ + skey) * 2048 + 1024 + h * 64 + spart * 8); } while (0)
#define STOREK(S, buf) do { LAS bf16* Ks_ = (LAS bf16*)(c.lds + (buf) * KBS); *(LAS u32x4*)(Ks_ + skey * KLD + spart * 8) = kreg##S; if (c.tid < 256) *(LAS u32x4*)(Ks_ + pkey * KLD + 64 + ppart * 8) = preg##S; } while (0)
#define STOREV(S, buf) do { LAS bf16* Vs_ = (LAS bf16*)(c.lds + VB0 + (buf) * VBS); *(LAS u32x4*)(Vs_ + skey * VLD + spart * 8) = vreg##S; } while (0)
#define QKT(d0, d1, buf) do { const LAS bf16* Ks_ = (const LAS bf16*)(c.lds + (buf) * KBS); d0 = zero16(); d1 = zero16(); \
    _Pragma("unroll") for (int ks = 0; ks < KS; ++ks) { const bf16x8 q_ = (ks < 4) ? Qf[ks & 3] : Qp[ks & 1]; \
      const bf16x8 A0_ = *(const LAS bf16x8*)(Ks_ + r * KLD + 16 * ks + 8 * hh); const bf16x8 A1_ = *(const LAS bf16x8*)(Ks_ + (32 + r) * KLD + 16 * ks + 8 * hh); \
      d0 = MFMA32(A0_, q_, d0); d1 = MFMA32(A1_, q_, d1); } } while (0)
#define PVT(buf) do { const LAS bf16* Vs_ = (const LAS bf16*)(c.lds + VB0 + (buf) * VBS); \
    _Pragma("unroll") for (int f = 0; f < 4; ++f) { const bf16x8 Pf_ = __builtin_bit_cast(bf16x8, pp[f]); const int vrow_ = 16 * f + 4 * hh + vq; \
      Ls = MFMA32(ones8, Pf_, Ls); \
      O0 = MFMA32(cat8(tr_read(Vs_ + vrow_ * VLD + vcol), tr_read(Vs_ + (vrow_ + 8) * VLD + vcol)), Pf_, O0); \
      O1 = MFMA32(cat8(tr_read(Vs_ + vrow_ * VLD + 32 + vcol), tr_read(Vs_ + (vrow_ + 8) * VLD + 32 + vcol)), Pf_, O1); } } while (0)
  LOADK(A, 0); LOADV(A, 0); LOADK(B, 1);
  STOREK(A, 0); STOREV(A, 0); STOREK(B, 1);
  LOADK(B, 2); LOADV(B, 1);
  __syncthreads();
  f32x16 c0, c1;
  QKT(c0, c1, 0);
  __syncthreads();
  f32x16 O0 = zero16(), O1 = zero16(), Ls = zero16();
  const bf16x8 ones8 = {(short)0x3f80, (short)0x3f80, (short)0x3f80, (short)0x3f80, (short)0x3f80, (short)0x3f80, (short)0x3f80, (short)0x3f80};
  float mrun = -1e30f;
  int vcur = 0, vnext = 1;
#define MLA_ITER(SL, SS) do { \
    { const int tk = min(t + 3, nt - 1), tv = min(t + 2, nt - 1); LOADK(SL, tk); LOADV(SL, tv); } \
    if (LAT && t + 1 == 32) { _Pragma("unroll") for (int k2 = 0; k2 < 2; ++k2) Qp[k2] = *(const bf16x8*)(qrow + 64 + 16 * k2); } \
    float tmax = -1e30f; \
    _Pragma("unroll") for (int reg = 0; reg < 16; ++reg) { tmax = fmax_nc(tmax, c0[reg]); tmax = fmax_nc(tmax, c1[reg]); } \
    tmax = fmaxf(tmax, __shfl_xor(tmax, 32)); \
    const float tm = tmax * sc2; \
    if (__builtin_amdgcn_ballot_w64(tm > mrun + 8.0f) != 0ull) { \
      const float mnew = fmaxf(mrun, tm); const float alpha = __builtin_amdgcn_exp2f(mrun - mnew); mrun = mnew; \
      _Pragma("unroll") for (int reg = 0; reg < 16; ++reg) { O0[reg] *= alpha; O1[reg] *= alpha; Ls[reg] *= alpha; } } \
    f32x16 n0, n1; \
    QKT(n0, n1, (t + 1) & 1); \
    _Pragma("unroll") for (int reg = 0; reg < 16; ++reg) { c0[reg] = __builtin_amdgcn_exp2f(fmaf(c0[reg], sc2, -mrun)); c1[reg] = __builtin_amdgcn_exp2f(fmaf(c1[reg], sc2, -mrun)); } \
    u32x4 pp[4]; \
    _Pragma("unroll") for (int sp = 0; sp < 2; ++sp) { \
      pp[sp] = (u32x4){pk2(c0[8 * sp + 0], c0[8 * sp + 1]), pk2(c0[8 * sp + 2], c0[8 * sp + 3]), pk2(c0[8 * sp + 4], c0[8 * sp + 5]), pk2(c0[8 * sp + 6], c0[8 * sp + 7])}; \
      pp[2 + sp] = (u32x4){pk2(c1[8 * sp + 0], c1[8 * sp + 1]), pk2(c1[8 * sp + 2], c1[8 * sp + 3]), pk2(c1[8 * sp + 4], c1[8 * sp + 5]), pk2(c1[8 * sp + 6], c1[8 * sp + 7])}; } \
    PVT(vcur); \
    c0 = n0; c1 = n1; \
    STOREK(SS, t & 1); STOREV(SS, vnext); \
    { const int nv = (vnext == 2) ? 0 : vnext + 1; vcur = vnext; vnext = nv; } \
    __syncthreads(); } while (0)
  if (w >= 4) __builtin_amdgcn_s_setprio(1);
  for (int t = 0; t < nt; t += 2) {
    MLA_ITER(A, B);
    ++t;
    MLA_ITER(B, A);
    --t;
  }
#undef MLA_ITER
  __builtin_amdgcn_s_setprio(0);
  { const float inv = 1.0f / Ls[0];
    bf16* op = AO + (size_t)m * D + h * 64;
#pragma unroll
    for (int eb = 0; eb < 2; ++eb)
#pragma unroll
      for (int gq = 0; gq < 4; ++gq) { const int e = eb * 32 + 8 * gq + 4 * hh;
        u32x2 wv; if (eb == 0) { wv.x = pk2(O0[4 * gq] * inv, O0[4 * gq + 1] * inv); wv.y = pk2(O0[4 * gq + 2] * inv, O0[4 * gq + 3] * inv); }
        else { wv.x = pk2(O1[4 * gq] * inv, O1[4 * gq + 1] * inv); wv.y = pk2(O1[4 * gq + 2] * inv, O1[4 * gq + 3] * inv); }
        *(u32x2*)(op + e) = wv; } }
  __syncthreads();
#undef MROW
#undef LOADK
#undef LOADV
#undef STOREK
#undef STOREV
#undef QKT
#undef PVT
}

#define XB_TMO      128
#define XB_XCNT(j)  (256  + 64 * (j))
#define XB_XSUB(j)  (1280 + 64 * (j))
#define XB_XGEN(j)  (2304 + 64 * (j))
#define XB_TOP      3328
#define XB_TOPGEN   3392
#define XCD_BAR_WORDS 3456
#define XB_SPIN_CAP (1u << 18)
DI unsigned xb_ld(unsigned* p)              { return __hip_atomic_load(p, __ATOMIC_RELAXED, __HIP_MEMORY_SCOPE_AGENT); }
DI unsigned xb_add(unsigned* p, unsigned v) { return __hip_atomic_fetch_add(p, v, __ATOMIC_RELAXED, __HIP_MEMORY_SCOPE_AGENT); }
DI unsigned xb_xcc_id() { return (unsigned)__builtin_amdgcn_s_getreg((3 << 11) | 20) & 0xFu; }
#define XB_SPIN(cond, bar) do { unsigned _sp = 0; while (cond) { __builtin_amdgcn_s_sleep(1); \
    if ((++_sp & 255u) == 0u) { if (xb_ld(&(bar)[XB_TMO])) break; if (_sp > XB_SPIN_CAP) { atomicAdd(&(bar)[XB_TMO], 1u); break; } } } } while (0)
struct XcdBarrier { unsigned* bar; unsigned x; volatile LAS unsigned* st; };
DI void xcd_barrier_post(unsigned* bar) { if (threadIdx.x == 0) (void)xb_add(&bar[XB_XCNT(xb_xcc_id())], 1u); }
DI void xcd_barrier_complete(unsigned* bar, unsigned x, unsigned& nloc, unsigned& nx) {
  const unsigned G = gridDim.x * gridDim.y * gridDim.z;
  unsigned sum, cnt, mine, sp = 0u;
  for (;;) {
    sum = 0u; cnt = 0u; mine = 0u;
#pragma unroll
    for (unsigned j = 0; j < 16; ++j) { const unsigned c = xb_ld(&bar[XB_XCNT(j)]); sum += c; cnt += (c > 0u) ? 1u : 0u; mine = (j == x) ? c : mine; }
    if (sum == G) break;
    __builtin_amdgcn_s_sleep(1);
    if ((++sp & 255u) == 0u) { if (xb_ld(&bar[XB_TMO])) break; if (sp > XB_SPIN_CAP) { atomicAdd(&bar[XB_TMO], 1u); break; } }
  }
  nloc = mine > 0u ? mine : 1u; nx = cnt > 0u ? cnt : 1u;
}
DI void xcd_barrier(const XcdBarrier& b) {
  asm volatile("s_waitcnt vmcnt(0)" ::: "memory");
  __syncthreads();
  if (threadIdx.x == 0) {
    unsigned* bar = b.bar;
    __builtin_amdgcn_s_waitcnt(0);
    unsigned nloc = b.st[0], nx = b.st[1];
    if (nloc == 0u) { xcd_barrier_complete(bar, b.x, nloc, nx); b.st[0] = nloc; b.st[1] = nx; }
    const unsigned old = xb_add(&bar[XB_XSUB(b.x)], 1u);
    const unsigned gen = old / nloc;
    if (old + 1u == (gen + 1u) * nloc) {
      __builtin_amdgcn_fence(__ATOMIC_RELEASE, "agent");
      asm volatile("s_waitcnt vmcnt(0)" ::: "memory");
      const unsigned og = xb_add(&bar[XB_TOP], 1u);
      const unsigned tg = og / nx;
      if (og + 1u == (tg + 1u) * nx) xb_add(&bar[XB_TOPGEN], 1u);
      else XB_SPIN(xb_ld(&bar[XB_TOPGEN]) == tg, bar);
      __builtin_amdgcn_fence(__ATOMIC_ACQUIRE, "agent");
      xb_add(&bar[XB_XGEN(b.x)], 1u);
      asm volatile("s_waitcnt vmcnt(0)" ::: "memory");
    } else {
      XB_SPIN(xb_ld(&bar[XB_XGEN(b.x)]) == gen, bar);
      __builtin_amdgcn_fence(__ATOMIC_ACQUIRE, "agent");
      asm volatile("s_waitcnt vmcnt(0)" ::: "memory");
    }
  }
  __syncthreads();
}
constexpr size_t WS_BAR = 65536;
constexpr int LDS_BARST = 139264;

#ifdef PROBE_MASK
#define TICK(slot) do { if (blockIdx.x == 0 && threadIdx.x == 0) { volatile unsigned long long* tw_ = (volatile unsigned long long*)a.ws; const unsigned long long now_ = __builtin_amdgcn_s_memrealtime(); \
    if ((PROBE_MASK >> (slot)) & 1) tw_[1] = tw_[1] + (now_ - tw_[0]); tw_[0] = now_; } } while (0)
#else
#define TICK(slot) do { } while (0)
#endif
#define RFL64(p) (((unsigned long long)(unsigned)__builtin_amdgcn_readfirstlane((int)((unsigned long long)(p) >> 32)) << 32) | (unsigned long long)(unsigned)__builtin_amdgcn_readfirstlane((int)(unsigned)(unsigned long long)(p)))
#define XSYNC1() do { XcdBarrier xb_; { unsigned long long bp_ = RFL64(a.ws + WS_BAR); asm volatile("" : "+s"(bp_)); xb_.bar = (unsigned*)(__attribute__((address_space(1))) unsigned*)bp_; } xb_.x = xb_xcc_id(); xb_.st = (volatile LAS unsigned*)((lptr)lds_raw + LDS_BARST); xcd_barrier(xb_); } while (0)
#ifdef DOUBLE_SYNC
#define GSYNC() do { XSYNC1(); XSYNC1(); } while (0)
#else
#define GSYNC() XSYNC1()
#endif
__global__ void __launch_bounds__(512, 2) mk_fwd(Args a) {
  extern __shared__ __attribute__((aligned(16))) unsigned char lds_raw[];
  cg::grid_group grid = cg::this_grid();
  const int wave0 = __builtin_amdgcn_readfirstlane((int)(threadIdx.x >> 6));
#define MAKE_CTX() Ctx c; { unsigned long long wsp_ = RFL64(a.ws), outp_ = RFL64(a.out); int z_ = 0; int lane_; int g_ = __builtin_amdgcn_readfirstlane((int)gridDim.x), b_ = __builtin_amdgcn_readfirstlane((int)blockIdx.x); \
    asm volatile("v_mbcnt_lo_u32_b32 %0, -1, 0\n\tv_mbcnt_hi_u32_b32 %0, -1, %0" : "=v"(lane_)); \
    asm volatile("" : "+s"(wsp_), "+s"(outp_), "+s"(z_), "+s"(g_), "+s"(b_)); const int tid_ = wave0 * 64 + lane_; \
    c.in = a.in + z_; c.out = (float*)(__attribute__((address_space(1))) float*)outp_; c.ws = (unsigned char*)(__attribute__((address_space(1))) unsigned char*)wsp_; c.lds = (lptr)lds_raw; c.tid = tid_; c.lane = lane_; c.wave = wave0; c.G = g_; c.bid = b_; c.zero = z_; } \
    unsigned char* ws = c.ws; bf16* Hb = (bf16*)(ws + WS_H); float* Yb = (float*)(ws + WS_Y); unsigned char* BIG = ws + WS_BIG; unsigned char* WA = ws + WS_WA; (void)Hb; (void)Yb; (void)BIG; (void)WA;
  if (threadIdx.x < 4) ((LAS unsigned*)((lptr)lds_raw + LDS_BARST))[threadIdx.x] = 0u;
  __syncthreads();
  xcd_barrier_post((unsigned*)(a.ws + WS_BAR));
#ifdef PROBE_MASK
  if (blockIdx.x == 0 && threadIdx.x == 0) { volatile unsigned long long* tw_ = (volatile unsigned long long*)a.ws; tw_[1] = 0ull; tw_[0] = __builtin_amdgcn_s_memrealtime(); }
#endif
#if !defined(PHASE_MASK) || (PHASE_MASK & 1)
  { MAKE_CTX(); prologue(c); }
  if (a.use_cg) grid.sync(); else GSYNC();
  { MAKE_CTX(); row_phase(c, 0, 0); }
  GSYNC();
  TICK(0);
#endif

  for (int l = 0; l < 4; ++l) {
    const int odd = l & 1, hl = l >> 1;
    const unsigned long long prog = odd ? 0x7C65BA984ull : 0x7C65B321ull;
    for (int st = 0; st < 9; ++st) {
      const int op = (int)((prog >> (4 * st)) & 15ull);
      if (op == 0) break;
#ifdef PHASE_MASK
      if (!((PHASE_MASK >> op) & 1)) continue;
#endif
      if (op == 1) { MAKE_CTX();
        pg8::Gemm g{Hb, (const bf16*)WA, NT, ACIN, D, D, D, ACIN / 256}; pg8::StaticOrder S; S.init(NT, ACIN, c.G, c.bid);
        pg8::EpiBf16<2> E{(bf16*)BIG, ACIN, c.out + O_NK + (size_t)hl * 8 * 256 * 64, c.out + O_NV + (size_t)hl * 8 * 256 * 64};
        pg8::gemm_phase(c.lds, g, S, E, c.tid);
      } else if (op == 2) { MAKE_CTX();
        const int vb = (c.G % 8 == 0) ? (c.bid % 8) * (c.G / 8) + c.bid / 8 : c.bid;
        for (int it = vb; it < 768 + 256 + 512; it += c.G) {
          if (it < 768) ret_kv_item(c, it, hl);
          else if (it < 1024) attn_item<0>(c, it - 768, hl);
          else attn_item<1>(c, it - 1024, hl);
        }
      } else if (op == 3) { MAKE_CTX();
        const int vb = (c.G % 8 == 0) ? (c.bid % 8) * (c.G / 8) + c.bid / 8 : c.bid;
        for (int it = vb; it < 768; it += c.G) ret_out_item(c, it, hl);
      } else if (op == 4) { MAKE_CTX();
        pg8::Gemm g{Hb, (const bf16*)WA, NT, CINP, D, D, D, CINP / 256}; pg8::EpiF32 E{(float*)BIG, CINP};
        pg8::StaticOrder S; S.init(g.M, g.N, c.G, c.bid);
        pg8::gemm_phase(c.lds, g, S, E, c.tid);
      } else if (op == 5) { MAKE_CTX();
        row_phase(c, l, 1);
      } else if (op == 6) { MAKE_CTX();
        pg8::Gemm g{Hb, (const bf16*)(ws + WS_W1T), NT, FF, D, D, D, FF / 256}; pg8::StaticOrder S; S.init(NT, FF, c.G, c.bid);
        pg8::EpiBf16<1> E{(bf16*)BIG, FF, nullptr, nullptr};
        pg8::gemm_phase(c.lds, g, S, E, c.tid);
      } else if (op == 7) { MAKE_CTX();
        row_phase(c, l, 2);
        if (l < 3) convert_weights(c, l + 1);
      } else if (op == 8) { MAKE_CTX();
        mla_rows(c, hl);
      } else if (op == 9 || op == 11 || op == 12) { MAKE_CTX();
        const int njobs = (op == 9) ? 2 : 1;
        for (int j = 0; j < njobs; ++j) {
          pg8::Gemm g; pg8::EpiBf16<0> E;
          if (op == 9) {
            if (j) { g = pg8::Gemm{(const bf16*)(ws + WS_H + H_CKVN), (const bf16*)(WA + WA_UKV), NT + NCTX, 2048, 256, 256, 256, 8}; E = pg8::EpiBf16<0>{(bf16*)(BIG + BIG_KV), 2048, nullptr, nullptr}; }
            else { g = pg8::Gemm{Hb, (const bf16*)(WA + WA_UQ), NT, 1536, 384, 384, 384, 6}; E = pg8::EpiBf16<0>{(bf16*)BIG, 1536, nullptr, nullptr}; }
          } else if (op == 11) { g = pg8::Gemm{Hb, (const bf16*)(WA + (odd ? WA_OUT_O : WA_OUT_E)), NT, D, D, D, D, 4}; E = pg8::EpiBf16<0>{(bf16*)Yb, D, nullptr, nullptr};
          } else { g = pg8::Gemm{(const bf16*)BIG, (const bf16*)(ws + WS_W2T), NT, 2 * D, FF / 2, FF, FF, 4}; E = pg8::EpiBf16<0>{(bf16*)Yb, 2 * D, nullptr, nullptr}; }
          pg8::StaticOrder S; S.init(g.M, g.N, c.G, (op == 9 && j) ? (c.bid + 3 * c.G / 4) % c.G : c.bid);
          pg8::gemm_phase(c.lds, g, S, E, c.tid);
        }
      } else if (op == 10) { MAKE_CTX();
        const int vb = (c.G % 8 == 0) ? (c.bid % 8) * (c.G / 8) + c.bid / 8 : c.bid;
        for (int it = vb; it < 512 + 1024; it += c.G) {
          if (it < 512) mla_item<0>(c, it); else mla_item<1>(c, it - 512);
        }
      }
      GSYNC();
      TICK(op);
    }
  }
#ifdef PROBE_MASK
  if (blockIdx.x == 0 && threadIdx.x == 0) { volatile unsigned long long* tw_ = (volatile unsigned long long*)a.ws; const unsigned long long wait_ = tw_[1] * 10ull, t0_ = __builtin_amdgcn_s_memrealtime();
    while (__builtin_amdgcn_s_memrealtime() - t0_ < wait_) __builtin_amdgcn_s_sleep(8); }
#endif
}

extern "C" void kernel_launch(void* const* d_in, const int* in_sizes, int n_in, void* d_out, int out_size, void* d_ws, size_t ws_size, hipStream_t stream) {
  static int grid = 0;
  if (grid == 0) {
    if (n_in != 27 || out_size != 50855936 || ws_size < WS_END) { fprintf(stderr, "kernel_launch: unexpected shapes (n_in %d out %d ws %zu)\n", n_in, out_size, ws_size); grid = -1; return; }
    int dev = 0, cus = 0, per_cu = 0;
    if (hipGetDevice(&dev) != hipSuccess || hipDeviceGetAttribute(&cus, hipDeviceAttributeMultiprocessorCount, dev) != hipSuccess) { grid = -1; return; }
    if (hipFuncSetAttribute((const void*)mk_fwd, hipFuncAttributeMaxDynamicSharedMemorySize, LDS_BYTES) != hipSuccess) { fprintf(stderr, "kernel_launch: hipFuncSetAttribute failed\n"); grid = -1; return; }
    if (hipOccupancyMaxActiveBlocksPerMultiprocessor(&per_cu, (const void*)mk_fwd, 512, LDS_BYTES) != hipSuccess || per_cu < 1) { fprintf(stderr, "kernel_launch: occupancy query says %d\n", per_cu); per_cu = 1; }
    (void)hipGetLastError();
    grid = cus;
  }
  if (grid < 0) return;
  Args a{};
  for (int i = 0; i < 27; ++i) a.in[i] = (const float*)d_in[i];
  a.out = (float*)d_out; a.ws = (unsigned char*)d_ws;
  if (hipMemsetAsync((char*)d_ws + WS_BAR, 0, 16384, stream) != hipSuccess) { fprintf(stderr, "kernel_launch: memset failed\n"); return; }
  void* args[] = {&a};
  hipError_t e = hipLaunchCooperativeKernel((const void*)mk_fwd, dim3(grid), dim3(512), args, LDS_BYTES, stream);
  if (e != hipSuccess) fprintf(stderr, "kernel_launch: cooperative launch failed: %s\n", hipGetErrorString(e));
}
```

```cpp
#include <hip/hip_runtime.h>
#include <hip/hip_cooperative_groups.h>
#include <cstdio>
namespace cg = cooperative_groups;

#define DI __device__ __forceinline__
#define LAS __attribute__((address_space(3)))
typedef unsigned short bf16;
typedef short bf16x8 __attribute__((ext_vector_type(8)));
typedef short s16x4 __attribute__((ext_vector_type(4)));
typedef float f32x4 __attribute__((ext_vector_type(4)));
typedef float f32x2 __attribute__((ext_vector_type(2)));
typedef float f32x16 __attribute__((ext_vector_type(16)));
typedef unsigned u32x4 __attribute__((ext_vector_type(4)));
typedef unsigned u32x2 __attribute__((ext_vector_type(2)));
typedef __bf16 bf16x2_t __attribute__((ext_vector_type(2)));
typedef LAS unsigned char* lptr;

#define LDS_WAIT() asm volatile("s_waitcnt lgkmcnt(0)" ::: "memory")
#define MFMA32(a, b, c) __builtin_amdgcn_mfma_f32_32x32x16_bf16((a), (b), (c), 0, 0, 0)

DI unsigned pk2(float lo, float hi) { f32x2 v = {lo, hi}; bf16x2_t b = __builtin_convertvector(v, bf16x2_t); return __builtin_bit_cast(unsigned, b); }
DI bf16 f2bf(float f) { return (bf16)(pk2(f, 0.f) & 0xffffu); }
DI float bf2f(unsigned b) { return __builtin_bit_cast(float, (b & 0xffffu) << 16); }
DI float bflo(unsigned w) { return __builtin_bit_cast(float, w << 16); }
DI float bfhi(unsigned w) { return __builtin_bit_cast(float, w & 0xffff0000u); }
DI float wave_sum(float v) {
#pragma unroll
  for (int o = 1; o < 64; o <<= 1) v += __shfl_xor(v, o);
  return v;
}
DI s16x4 tr_read(const LAS bf16* p) { return __builtin_amdgcn_ds_read_tr16_b64_v4i16((LAS s16x4*)p); }
DI bf16x8 cat8(s16x4 lo, s16x4 hi) { return __builtin_shufflevector(lo, hi, 0, 1, 2, 3, 4, 5, 6, 7); }
DI float fmax_nc(float a, float b) { return __builtin_amdgcn_fmed3f(a, b, __builtin_inff()); }
DI int crow(int reg, int h) { return (reg & 3) + 8 * (reg >> 2) + 4 * h; }
DI f32x16 zero16() { f32x16 z; for (int i = 0; i < 16; ++i) z[i] = 0.f; return z; }

constexpr int D = 1024, NP = 8192, NS = 16384, NT = 24576, FF = 4096, ACIN = 3584, CINP = 768, NCTX = 2048;
constexpr float EPS = 1e-6f, LOG2E = 1.4426950408889634f;
constexpr size_t O_RF = 25165824, O_RB = 27262976, O_NK = 29360128, O_NV = 37748736, O_CKV = 46137344, O_KPE = 50331648;
constexpr size_t MiB = 1u << 20;
constexpr size_t WS_MOD = 1 * MiB, WS_ROPE = 2 * MiB, WS_KPE = 3 * MiB, WS_NACTX = 5 * MiB;
constexpr size_t WS_W1T = 13 * MiB, WS_W2T = 21 * MiB, WS_WA = 29 * MiB;
constexpr size_t WS_H = 40 * MiB, WS_Y = 88 * MiB, WS_BIG = 184 * MiB, WS_END = 376 * MiB;
constexpr size_t WA_OUT_E = 7 * MiB, WA_UQ = 1536 * 1024, WA_UKV = 3 * MiB, WA_OUT_O = 4 * MiB;
constexpr size_t H_CKVN = 20 * MiB;
constexpr size_t Y_KVB = 24 * MiB;
constexpr size_t BIG_KV = 72 * MiB;
constexpr int LDS_BYTES = 147456;

struct Args { const float* in[27]; float* out; unsigned char* ws; unsigned long long use_cg; };

namespace pg8 {
constexpr int BM = 256, BK = 64, HALF = 128, HTB = HALF * BK * 2, NXCD = 8, WGM = 8;
DI int lds_byte(int r, int c) { const int st = (r >> 4) * 2 + (c >> 5), rr = r & 15, cc = c & 31, ob = rr * 64 + cc * 2; return st * 1024 + (ob ^ (((ob >> 9) & 1) << 5)); }
DI void stage_rc(int b, int& R, int& C) { const int st = b / 1024, sb = b % 1024, swz = sb ^ (((sb >> 9) & 1) << 5); R = (st >> 1) * 16 + swz / 64; C = (st & 1) * 32 + (swz % 64) / 2; }
DI int perm32(int rho) { const int n = rho >> 4, i = rho & 15; return 8 * (i >> 2) + 4 * n + (i & 3); }
struct Unit { int pm, pn; };
struct Gemm { const bf16* A; const bf16* Bt; int M, N, K, lda, ldb, nNreal; };
struct StaticOrder {
  int nM, nN, nwg, G, c;
  DI void init(int M, int N, int G_, int c_) { nM = M / BM; nN = N / BM; nwg = nM * nN; G = G_; c = c_; }
  DI bool next(int i, Unit& u) const {
    const long L = (long)i * G + c; if (L >= nwg) return false;
    int wgid = (int)L; { const int q = nwg / NXCD, r = nwg % NXCD, xcd = wgid % NXCD, off = wgid / NXCD; wgid = (xcd < r ? xcd * (q + 1) : r * (q + 1) + (xcd - r) * q) + off; }
    const int nig = WGM * nN, gid = wgid / nig, fm = gid * WGM, gsz = (nM - fm) < WGM ? (nM - fm) : WGM;
    u.pm = fm + ((wgid % nig) % gsz); u.pn = (wgid % nig) / gsz; return true;
  }
};
struct EpiF32 {
  static constexpr bool PERM = false;
  float* C; int ldc;
  DI void operator()(const f32x4 (&acc)[2][2][4][2], const Unit& u, int wr, int wc, int fr, int fq) const {
    const int row0 = u.pm * BM + wr * 64 + fr, col0 = u.pn * BM + wc * 32 + 4 * fq;
#pragma unroll
    for (int ai = 0; ai < 2; ++ai)
#pragma unroll
      for (int m = 0; m < 4; ++m) { float* rowp = C + (size_t)(row0 + ai * HALF + m * 16) * ldc + col0;
#pragma unroll
        for (int bj = 0; bj < 2; ++bj)
#pragma unroll
          for (int n = 0; n < 2; ++n) *(f32x4*)(rowp + bj * HALF + n * 16) = acc[ai][bj][m][n]; }
  }
};
template <int MODE> struct EpiBf16 {
  static constexpr bool PERM = true;
  bf16* O; int ldc; float* nk_out; float* nv_out;
  DI void operator()(const f32x4 (&acc)[2][2][4][2], const Unit& u, int wr, int wc, int fr, int fq) const {
    const int row0 = u.pm * BM + wr * 64 + fr; const int col0 = u.pn * BM + wc * 32 + 8 * fq;
    const float sc = (MODE == 2 && (u.pn == 2 || u.pn == 3)) ? 0.125f : 1.0f;
    const bool side = (MODE == 2) && (u.pn >= 10) && (u.pm < 32);
    float* sbase = (u.pn >= 12) ? nv_out : nk_out;
    const int scol0 = col0 - ((u.pn >= 12) ? 3072 : 2560);
#pragma unroll
    for (int ai = 0; ai < 2; ++ai)
#pragma unroll
      for (int m = 0; m < 4; ++m) { const int row = row0 + ai * HALF + m * 16; bf16* rowp = O + (size_t)row * ldc + col0;
#pragma unroll
        for (int bj = 0; bj < 2; ++bj) { f32x4 v0 = acc[ai][bj][m][0], v1 = acc[ai][bj][m][1];
          if (MODE == 1) {
#pragma unroll
            for (int j = 0; j < 4; ++j) { float a = fmaxf(v0[j], 0.f), b = fmaxf(v1[j], 0.f); v0[j] = a * a; v1[j] = b * b; } }
          if (MODE == 2) { v0 = v0 * sc; v1 = v1 * sc; }
          u32x4 w; w.x = pk2(v0[0], v0[1]); w.y = pk2(v0[2], v0[3]); w.z = pk2(v1[0], v1[1]); w.w = pk2(v1[2], v1[3]);
          *(u32x4*)(rowp + bj * HALF) = w;
          if (MODE == 2) { if (side) { const int cc = scol0 + bj * HALF; const int hh = cc >> 6, dd = cc & 63; const int b = row >> 8, s = row & 255;
              float* dst = sbase + ((size_t)((b * 2) * 8 + hh) * 256 + s) * 64 + dd;
              *(f32x4*)dst = v0; *(f32x4*)(dst + 4) = v1; } }
        } }
  }
};

template <class Epi>
DI void gemm_phase(lptr lds, const Gemm g, const StaticOrder& S, const Epi& E, const int tid) {
  const int wid = __builtin_amdgcn_readfirstlane(tid >> 6), lane = tid & 63, wr = wid >> 2, wc = wid & 3, fr = lane & 15, fq = lane >> 4;
  const int K = g.K, nt = K / BK;
  unsigned voffA[2], voffB[2];
#pragma unroll
  for (int i = 0; i < 2; ++i) { int R, C; stage_rc(tid * 16 + i * 8192, R, C); const int Rb = Epi::PERM ? ((R & ~31) + perm32(R & 31)) : R;
    voffA[i] = (unsigned)(R * g.lda + C) * 2u; voffB[i] = (unsigned)(Rb * g.ldb + C) * 2u; }
  const size_t kstep = (size_t)(BK * 2);
  const size_t hstepA = (size_t)HALF * g.lda * 2, hstepB = (size_t)HALF * g.ldb * 2;
  const size_t tstepA = 2 * hstepA, tstepB = 2 * hstepB; const int nNr = g.nNreal; const size_t ksl = (size_t)K * 2;
  const unsigned ldsw = (unsigned)wid * 1024u;
  const int aoff = lds_byte(wr * 64 + fr, fq * 8), boff = lds_byte(wc * 32 + fr, fq * 8);
#define PG8_SA(b, h) (((b) * 2 + (h)) * HTB)
#define PG8_SB(b, h) ((4 + (b) * 2 + (h)) * HTB)
#define PG8_STAGE(bufoff, gbase, voff) do { _Pragma("unroll") for (int _i = 0; _i < 2; ++_i) \
    __builtin_amdgcn_global_load_lds((const unsigned*)((const char*)(gbase) + (voff)[_i]), (LAS unsigned*)(lds + (bufoff) + ldsw + _i * 8192), 16, 0, 0); } while (0)
#define PG8_LDA(dst, b, h) do { _Pragma("unroll") for (int m = 0; m < 4; ++m) _Pragma("unroll") for (int k = 0; k < 2; ++k) dst[m][k] = *(const LAS bf16x8*)(lds + PG8_SA(b, h) + aoff + m * 2048 + k * 1024); } while (0)
#define PG8_LDB(dst, b, h) do { _Pragma("unroll") for (int n = 0; n < 2; ++n) _Pragma("unroll") for (int k = 0; k < 2; ++k) dst[n][k] = *(const LAS bf16x8*)(lds + PG8_SB(b, h) + boff + n * 2048 + k * 1024); } while (0)
#define PG8_MMA(ai, bj, At, Bt) do { __builtin_amdgcn_s_setprio(1); _Pragma("unroll") for (int m = 0; m < 4; ++m) _Pragma("unroll") for (int n = 0; n < 2; ++n) _Pragma("unroll") for (int k = 0; k < 2; ++k) \
    acc[ai][bj][m][n] = __builtin_amdgcn_mfma_f32_16x16x32_bf16(Bt[n][k], At[m][k], acc[ai][bj][m][n], 0, 0, 0); __builtin_amdgcn_s_setprio(0); } while (0)
#define PG8_WAIT_V(n) asm volatile("s_waitcnt vmcnt(" #n ")" ::: "memory")
#define PG8_WAIT_L(n) asm volatile("s_waitcnt lgkmcnt(" #n ")" ::: "memory")
#define PG8_BAR __builtin_amdgcn_s_barrier()
#define PG8_SCHED __builtin_amdgcn_sched_barrier(0)
  Unit cur, nxt; int ui = 0;
  if (!S.next(0, cur)) return;
  f32x4 acc[2][2][4][2];
#pragma unroll
  for (int a = 0; a < 2; ++a)
#pragma unroll
    for (int b = 0; b < 2; ++b)
#pragma unroll
      for (int m = 0; m < 4; ++m)
#pragma unroll
        for (int n = 0; n < 2; ++n) acc[a][b][m][n] = (f32x4){0.f, 0.f, 0.f, 0.f};
  bf16x8 At[4][2], B0[2][2], B1[2][2];
  const char* cA = (const char*)g.A + (size_t)cur.pm * tstepA + (size_t)(cur.pn / nNr) * ksl; const char* cB = (const char*)g.Bt + (size_t)(cur.pn % nNr) * tstepB + (size_t)(cur.pn / nNr) * ksl;
  PG8_STAGE(PG8_SB(0, 0), cB, voffB); PG8_STAGE(PG8_SA(0, 0), cA, voffA); PG8_STAGE(PG8_SB(0, 1), cB + hstepB, voffB); PG8_STAGE(PG8_SA(0, 1), cA + hstepA, voffA);
  if (wr == 1) PG8_BAR;
  PG8_WAIT_V(4); PG8_BAR;
  PG8_STAGE(PG8_SB(1, 0), cB + kstep, voffB); PG8_STAGE(PG8_SA(1, 0), cA + kstep, voffA); PG8_STAGE(PG8_SB(1, 1), cB + hstepB + kstep, voffB);
  PG8_WAIT_V(6); PG8_BAR;
  for (;;) {
    const bool has_next = S.next(ui + 1, nxt);
    const char* nA = has_next ? (const char*)g.A + (size_t)nxt.pm * tstepA + (size_t)(nxt.pn / nNr) * ksl : cA; const char* nB = has_next ? (const char*)g.Bt + (size_t)(nxt.pn % nNr) * tstepB + (size_t)(nxt.pn / nNr) * ksl : cB;
    for (int t = 0; t < nt; t += 2) {
      const bool last = (t == nt - 2);
      const char* a1 = cA + (size_t)(t + 1) * kstep;
      const char* a2 = last ? nA : cA + (size_t)(t + 2) * kstep; const char* b2 = last ? nB : cB + (size_t)(t + 2) * kstep;
      const char* a3 = a2 + kstep; const char* b3 = b2 + kstep;
      PG8_LDB(B0, 0, 0); PG8_SCHED; PG8_LDA(At, 0, 0); PG8_STAGE(PG8_SA(1, 1), a1 + hstepA, voffA);
      PG8_WAIT_L(8); PG8_BAR; PG8_WAIT_L(0); PG8_MMA(0, 0, At, B0); PG8_BAR; PG8_SCHED;
      PG8_LDB(B1, 0, 1); PG8_STAGE(PG8_SB(0, 0), b2, voffB);
      PG8_BAR; PG8_WAIT_L(0); PG8_MMA(0, 1, At, B1); PG8_BAR;
      PG8_LDA(At, 0, 1); PG8_STAGE(PG8_SA(0, 0), a2, voffA);
      PG8_BAR; PG8_WAIT_L(0); PG8_MMA(1, 0, At, B0); PG8_BAR; PG8_SCHED;
      PG8_STAGE(PG8_SB(0, 1), b2 + hstepB, voffB);
      PG8_WAIT_V(6); PG8_BAR; PG8_MMA(1, 1, At, B1); PG8_BAR;
      PG8_LDB(B0, 1, 0); PG8_SCHED; PG8_LDA(At, 1, 0); PG8_STAGE(PG8_SA(0, 1), a2 + hstepA, voffA);
      PG8_WAIT_L(8); PG8_BAR; PG8_WAIT_L(0); PG8_MMA(0, 0, At, B0); PG8_BAR; PG8_SCHED;
      PG8_LDB(B1, 1, 1); PG8_STAGE(PG8_SB(1, 0), b3, voffB);
      PG8_BAR; PG8_WAIT_L(0); PG8_MMA(0, 1, At, B1); PG8_BAR;
      PG8_LDA(At, 1, 1); PG8_STAGE(PG8_SA(1, 0), a3, voffA);
      PG8_BAR; PG8_WAIT_L(0); PG8_MMA(1, 0, At, B0); PG8_BAR; PG8_SCHED;
      PG8_STAGE(PG8_SB(1, 1), b3 + hstepB, voffB);
      PG8_WAIT_V(6); PG8_BAR; PG8_MMA(1, 1, At, B1); PG8_BAR;
    }
    E(acc, cur, wr, wc, fr, fq);
    if (!has_next) break;
#pragma unroll
    for (int a = 0; a < 2; ++a)
#pragma unroll
      for (int b = 0; b < 2; ++b)
#pragma unroll
        for (int m = 0; m < 4; ++m)
#pragma unroll
          for (int n = 0; n < 2; ++n) acc[a][b][m][n] = (f32x4){0.f, 0.f, 0.f, 0.f};
    cur = nxt; cA = nA; cB = nB; ++ui;
  }
  PG8_WAIT_V(0);
  if (wr == 0) PG8_BAR;
  PG8_BAR;
#undef PG8_SA
#undef PG8_SB
#undef PG8_STAGE
#undef PG8_LDA
#undef PG8_LDB
#undef PG8_MMA
#undef PG8_WAIT_V
#undef PG8_WAIT_L
#undef PG8_BAR
#undef PG8_SCHED
}
}

struct Ctx {
  const float* const* in; float* out; unsigned char* ws; lptr lds;
  int tid, lane, wave, G, bid, zero;
};
DI float log_decay2(float p) { return log1pf(-exp2f(p)) * LOG2E; }

DI void transpose_item(const float* W, int K, int N, bf16* WT, int row_off, LAS float* scr, int item, int lane) {
  const int nblk = N / 32, kb = item / nblk, nb = item % nblk, k0 = 64 * kb, n0 = 32 * nb;
  float tv[32];
#pragma unroll
  for (int i = 0; i < 32; ++i) { const int kk = 2 * i + (lane >> 5); tv[i] = W[(size_t)(k0 + kk) * N + n0 + (lane & 31)]; }
#pragma unroll
  for (int i = 0; i < 32; ++i) { const int kk = 2 * i + (lane >> 5); scr[kk * 33 + (lane & 31)] = tv[i]; }
  LDS_WAIT(); asm volatile("" ::: "memory");
  const int c = lane & 7;
#pragma unroll
  for (int j = 0; j < 4; ++j) { const int n = (lane >> 3) + 8 * j; const LAS float* s = scr + (8 * c) * 33 + n;
    u32x4 o; o.x = pk2(s[0 * 33], s[1 * 33]); o.y = pk2(s[2 * 33], s[3 * 33]); o.z = pk2(s[4 * 33], s[5 * 33]); o.w = pk2(s[6 * 33], s[7 * 33]);
    *(u32x4*)(WT + (size_t)(row_off + n0 + n) * K + k0 + 8 * c) = o; }
  LDS_WAIT(); asm volatile("" ::: "memory");
}
DI void convert_weights(const Ctx& c, int l) {
  LAS float* scr = (LAS float*)(c.lds + c.wave * 16384);
  const int gw = c.bid * 8 + c.wave, NGW = c.G * 8;
  bf16* W1T = (bf16*)(c.ws + WS_W1T); bf16* W2T = (bf16*)(c.ws + WS_W2T); unsigned char* WA = c.ws + WS_WA;
  const int hl = l >> 1;
  const float* w1 = c.in[13] + (size_t)l * D * FF; const float* w2 = c.in[14] + (size_t)l * FF * D;
  constexpr int I1 = 16 * 128, I2 = 64 * 32;
  if ((l & 1) == 0) {
    const float* win = c.in[15] + (size_t)hl * D * ACIN; const float* wout = c.in[16] + (size_t)hl * D * D;
    constexpr int IA = 16 * 112, IB = 16 * 32;
    for (int it = gw; it < I1 + I2 + IA + IB; it += NGW) {
      int r = it;
      if (r < I1) { transpose_item(w1, D, FF, W1T, 0, scr, r, c.lane); continue; } r -= I1;
      if (r < I2) { transpose_item(w2, FF, D, W2T, 0, scr, r, c.lane); continue; } r -= I2;
      if (r < IA) { transpose_item(win, D, ACIN, (bf16*)WA, 0, scr, r, c.lane); continue; } r -= IA;
      transpose_item(wout, D, D, (bf16*)(WA + WA_OUT_E), 0, scr, r, c.lane);
    }
  } else {
    const float* winc = c.in[20] + (size_t)hl * D * 672; const float* wuq = c.in[23] + (size_t)hl * 384 * 1536;
    const float* wuk = c.in[24] + (size_t)hl * 256 * 1024; const float* wuv = c.in[25] + (size_t)hl * 256 * 1024; const float* woc = c.in[26] + (size_t)hl * D * D;
    constexpr int IA = 16 * 21, IB = 6 * 48, IC = 4 * 32, ID = 16 * 32;
    for (int it = gw; it < I1 + I2 + IA + IB + 2 * IC + ID; it += NGW) {
      int r = it;
      if (r < I1) { transpose_item(w1, D, FF, W1T, 0, scr, r, c.lane); continue; } r -= I1;
      if (r < I2) { transpose_item(w2, FF, D, W2T, 0, scr, r, c.lane); continue; } r -= I2;
      if (r < IA) { transpose_item(winc, D, 672, (bf16*)WA, 0, scr, r, c.lane); continue; } r -= IA;
      if (r < IB) { transpose_item(wuq, 384, 1536, (bf16*)(WA + WA_UQ), 0, scr, r, c.lane); continue; } r -= IB;
      if (r < IC) { transpose_item(wuk, 256, 1024, (bf16*)(WA + WA_UKV), 0, scr, r, c.lane); continue; } r -= IC;
      if (r < IC) { transpose_item(wuv, 256, 1024, (bf16*)(WA + WA_UKV), 1024, scr, r, c.lane); continue; } r -= IC;
      transpose_item(woc, D, D, (bf16*)(WA + WA_OUT_O), 0, scr, r, c.lane);
    }
    u32x4* z = (u32x4*)(WA + (size_t)672 * D * 2);
    for (int i = c.bid * 512 + c.tid; i < 96 * D * 2 / 16; i += c.G * 512) z[i] = (u32x4){(unsigned)c.zero, (unsigned)c.zero, (unsigned)c.zero, (unsigned)c.zero};
  }
}

DI void prologue(const Ctx& c) {
  float* MOD = (float*)(c.ws + WS_MOD);
  for (int item = c.bid; item < 4 * 48; item += c.G) {
    const int l = item / 48, n0 = (item % 48) * 128;
    LAS float* sil = (LAS float*)c.lds; LAS float* red = (LAS float*)(c.lds + 36864);
    for (int i = c.tid; i < 9 * 1024; i += 512) { const int r = i >> 10, k = i & 1023; const float x = (r == 0) ? c.in[9][k] : c.in[8][(r - 1) * 1024 + k]; sil[i] = x / (1.f + __expf(-x)); }
    __syncthreads();
    float acc[9][2];
#pragma unroll
    for (int r = 0; r < 9; ++r) { acc[r][0] = 0.f; acc[r][1] = 0.f; }
    const float* wp = c.in[10] + ((size_t)l * 1024 + c.wave * 128) * 6144 + n0 + 2 * c.lane;
#pragma unroll 8
    for (int k = 0; k < 128; ++k) { const f32x2 w = *(const f32x2*)(wp + (size_t)k * 6144);
#pragma unroll
      for (int r = 0; r < 9; ++r) { const float s = sil[r * 1024 + c.wave * 128 + k]; acc[r][0] += s * w.x; acc[r][1] += s * w.y; } }
#pragma unroll
    for (int r = 0; r < 9; ++r) { red[(c.wave * 9 + r) * 128 + 2 * c.lane] = acc[r][0]; red[(c.wave * 9 + r) * 128 + 2 * c.lane + 1] = acc[r][1]; }
    __syncthreads();
    for (int o = c.tid; o < 9 * 128; o += 512) { const int r = o >> 7, n = o & 127; float s = c.in[11][l * 6144 + n0 + n];
#pragma unroll
      for (int w = 0; w < 8; ++w) s += red[(w * 9 + r) * 128 + n];
      MOD[(size_t)(l * 9 + r) * 6144 + n0 + n] = s; }
    __syncthreads();
  }
  { float* RC = (float*)(c.ws + WS_ROPE); float* RS = RC + 32768;
    for (int i = c.bid * 512 + c.tid; i < 2048 * 16; i += c.G * 512) { const int t = i >> 4, j = i & 15; const float pos = (float)((j < 8) ? (t >> 6) : (t & 63));
      const float inv = exp2f(-(float)(j & 7) * 0.125f * 13.287712379549449f); const float a = pos * inv;
      const float k = rintf(a * 0.15915494309189535f); float r = fmaf(-k, 6.2831854820251465f, a); r = fmaf(k, 1.7484556e-07f, r);
      RC[i] = __cosf(r); RS[i] = __sinf(r); } }
  { bf16* NC = (bf16*)(c.ws + WS_NACTX);
    for (int i = c.bid * 512 + c.tid; i < 2 * 2 * 8 * 8 * 256 * 16; i += c.G * 512) {
      const int e4 = i & 15, key = (i >> 4) & 255, h = (i >> 12) & 7, b = (i >> 15) & 7, kv = (i >> 18) & 1, ia = (i >> 19) & 1;
      const f32x4 v = *(const f32x4*)(c.in[4 + kv] + ((((size_t)b * 2 + ia) * 8 + h) * 256 + key) * 64 + 4 * e4);
      u32x2 o; o.x = pk2(v[0], v[1]); o.y = pk2(v[2], v[3]); *(u32x2*)(NC + (size_t)i * 4) = o; } }
  convert_weights(c, 0);
}

DI void row_phase(const Ctx& c, int l, int kind) {
  const float* MOD = (const float*)(c.ws + WS_MOD); const float* NG = c.in[12];
  const bf16* Y = (const bf16*)(c.ws + WS_Y); bf16* Hb = (bf16*)(c.ws + WS_H);
  const int gw = c.bid * 8 + c.wave, NGW = c.G * 8;
  const int hl = (kind == 2) ? l + 1 : l;
  const bool want_h = hl < 4;
  const float* gy = NG + (size_t)(l * 4 + (kind == 1 ? 1 : 3)) * D;
  const float* gh = NG + (size_t)((want_h ? hl : 0) * 4 + (kind == 1 ? 2 : 0)) * D;
  constexpr int RB = 2;
#define ROFF(q) (8 * (c.lane + 64 * ((q) >> 1)) + 4 * ((q) & 1))
#define ROW_LOAD(X, YA, YB, M0) do { \
    _Pragma("unroll") for (int k = 0; k < RB; ++k) { const int m = (M0) + k * NGW; if (m < NT) { \
      const float* xs = (kind == 0 || (kind == 1 && l == 0)) ? ((m < NP) ? c.in[0] + (size_t)m * D : c.in[1] + (size_t)(m - NP) * D) : c.out + (size_t)m * D; \
      _Pragma("unroll") for (int j = 0; j < 2; ++j) { const int o = 8 * (c.lane + 64 * j); \
        if (kind == 1) YA[k][j] = *(const u32x4*)(Y + (size_t)m * D + o); \
        if (kind == 2) { YA[k][j] = *(const u32x4*)(Y + (size_t)m * 2 * D + o); YB[k][j] = *(const u32x4*)(Y + (size_t)m * 2 * D + D + o); } \
        X[k][2 * j] = *(const f32x4*)(xs + o); X[k][2 * j + 1] = *(const f32x4*)(xs + o + 4); } } } } while (0)
#define ROW_PROC(X, YA, YB, M0) do { \
    _Pragma("unroll") for (int k = 0; k < RB; ++k) { const int m = (M0) + k * NGW; if (m < NT) { \
      const int r = (m < NP) ? 0 : 1 + ((m - NP) >> 11); \
      float* xo = c.out + (size_t)m * D; \
      if (kind != 0) { \
        const float* gate = MOD + ((size_t)(l * 9 + r) * 6 + (kind == 1 ? 2 : 5)) * D; \
        f32x4 y[4]; \
        _Pragma("unroll") for (int j = 0; j < 2; ++j) { const u32x4 w = YA[k][j]; \
          y[2 * j] = (f32x4){bflo(w.x), bfhi(w.x), bflo(w.y), bfhi(w.y)}; y[2 * j + 1] = (f32x4){bflo(w.z), bfhi(w.z), bflo(w.w), bfhi(w.w)}; \
          if (kind == 2) { const u32x4 w2 = YB[k][j]; \
            y[2 * j] += (f32x4){bflo(w2.x), bfhi(w2.x), bflo(w2.y), bfhi(w2.y)}; y[2 * j + 1] += (f32x4){bflo(w2.z), bfhi(w2.z), bflo(w2.w), bfhi(w2.w)}; } } \
        float ss = 0.f; \
        _Pragma("unroll") for (int q = 0; q < 4; ++q) ss += y[q][0] * y[q][0] + y[q][1] * y[q][1] + y[q][2] * y[q][2] + y[q][3] * y[q][3]; \
        const float rs = 1.0f / sqrtf(wave_sum(ss) * (1.f / D) + EPS); \
        _Pragma("unroll") for (int q = 0; q < 4; ++q) { const f32x4 g = *(const f32x4*)(gy + ROFF(q)); const f32x4 gt = *(const f32x4*)(gate + ROFF(q)); \
          X[k][q] = X[k][q] + gt * (y[q] * rs * g); } \
        _Pragma("unroll") for (int q = 0; q < 4; ++q) *(f32x4*)(xo + ROFF(q)) = X[k][q]; \
      } \
      if (want_h) { \
        const float* shift = MOD + ((size_t)(hl * 9 + r) * 6 + (kind == 1 ? 3 : 0)) * D; const float* scale = shift + D; \
        float ss = 0.f; \
        _Pragma("unroll") for (int q = 0; q < 4; ++q) ss += X[k][q][0] * X[k][q][0] + X[k][q][1] * X[k][q][1] + X[k][q][2] * X[k][q][2] + X[k][q][3] * X[k][q][3]; \
        const float rs = 1.0f / sqrtf(wave_sum(ss) * (1.f / D) + EPS); \
        _Pragma("unroll") for (int j = 0; j < 2; ++j) { u32x4 w; \
          _Pragma("unroll") for (int hf = 0; hf < 2; ++hf) { const int q = 2 * j + hf, o = ROFF(q); const f32x4 g = *(const f32x4*)(gh + o); const f32x4 sh = *(const f32x4*)(shift + o); const f32x4 sc = *(const f32x4*)(scale + o); \
            const f32x4 hv = (X[k][q] * rs * g) * (sc + 1.0f) + sh; \
            if (hf == 0) { w.x = pk2(hv[0], hv[1]); w.y = pk2(hv[2], hv[3]); } else { w.z = pk2(hv[0], hv[1]); w.w = pk2(hv[2], hv[3]); } } \
          *(u32x4*)(Hb + (size_t)m * D + 8 * (c.lane + 64 * j)) = w; } \
      } } } } while (0)
  f32x4 xA[RB][4], xB[RB][4]; u32x4 yaA[RB][2], ybA[RB][2], yaB[RB][2], ybB[RB][2];
  const int step = RB * NGW;
  int m0 = gw;
  ROW_LOAD(xA, yaA, ybA, m0);
  for (; m0 < NT; m0 += 2 * step) {
    ROW_LOAD(xB, yaB, ybB, m0 + step);
    ROW_PROC(xA, yaA, ybA, m0);
    ROW_LOAD(xA, yaA, ybA, m0 + 2 * step);
    ROW_PROC(xB, yaB, ybB, m0 + step);
  }
#undef ROW_LOAD
#undef ROW_PROC
#undef ROFF
}

DI void mla_rows(const Ctx& c, int ic) {
  const float* Cb = (const float*)(c.ws + WS_BIG); bf16* CQ = (bf16*)(c.ws + WS_H); bf16* CKV = (bf16*)(c.ws + WS_H + H_CKVN); bf16* KPE = (bf16*)(c.ws + WS_KPE);
  const float* RC = (const float*)(c.ws + WS_ROPE); const float* RS = RC + 32768;
  const float* qn = c.in[21] + ic * 384; const float* kvn = c.in[22] + ic * 256;
  const int gw = c.bid * 8 + c.wave, NGW = c.G * 8;
  constexpr int RB = 3;
  const bool ql = c.lane < 48;
  for (int m0 = gw; m0 < NT; m0 += RB * NGW) {
    f32x4 qa[RB], qb[RB], kv[RB]; float xk[RB];
#pragma unroll
    for (int k = 0; k < RB; ++k) { const int m = m0 + k * NGW; if (m < NT) { const float* cr = Cb + (size_t)m * CINP;
      qa[k] = ql ? *(const f32x4*)(cr + 8 * c.lane) : (f32x4){0.f, 0.f, 0.f, 0.f}; qb[k] = ql ? *(const f32x4*)(cr + 8 * c.lane + 4) : (f32x4){0.f, 0.f, 0.f, 0.f};
      kv[k] = *(const f32x4*)(cr + 384 + 4 * c.lane); xk[k] = cr[640 + (c.lane & 31)]; } }
#pragma unroll
    for (int k = 0; k < RB; ++k) { const int m = m0 + k * NGW; if (m < NT) {
      float ss = qa[k][0] * qa[k][0] + qa[k][1] * qa[k][1] + qa[k][2] * qa[k][2] + qa[k][3] * qa[k][3] + qb[k][0] * qb[k][0] + qb[k][1] * qb[k][1] + qb[k][2] * qb[k][2] + qb[k][3] * qb[k][3];
      float rs = 1.0f / sqrtf(wave_sum(ss) * (1.f / 384.f) + EPS);
      if (ql) { const f32x4 g0 = *(const f32x4*)(qn + 8 * c.lane), g1 = *(const f32x4*)(qn + 8 * c.lane + 4); const f32x4 a = qa[k] * rs * g0, b = qb[k] * rs * g1;
        u32x4 w; w.x = pk2(a[0], a[1]); w.y = pk2(a[2], a[3]); w.z = pk2(b[0], b[1]); w.w = pk2(b[2], b[3]); *(u32x4*)(CQ + (size_t)m * 384 + 8 * c.lane) = w; }
      ss = kv[k][0] * kv[k][0] + kv[k][1] * kv[k][1] + kv[k][2] * kv[k][2] + kv[k][3] * kv[k][3];
      rs = 1.0f / sqrtf(wave_sum(ss) * (1.f / 256.f) + EPS);
      const f32x4 kn = kv[k] * rs * *(const f32x4*)(kvn + 4 * c.lane);
      u32x2 w; w.x = pk2(kn[0], kn[1]); w.y = pk2(kn[2], kn[3]); *(u32x2*)(CKV + (size_t)m * 256 + 4 * c.lane) = w;
      const float pk = __shfl_xor(xk[k], 1);
      if (m < NP) { const int b = m >> 8, s = m & 255; const size_t slot = ((size_t)(b * 2 + ic) * 256 + s);
        *(f32x4*)(c.out + O_CKV + slot * 256 + 4 * c.lane) = kn;
        if (c.lane < 32) { c.out[O_KPE + slot * 32 + c.lane] = xk[k]; KPE[(size_t)m * 32 + c.lane] = f2bf(xk[k]); }
      } else { const int pos = (m - NP) & 2047; const int pi = (c.lane & 31) >> 1; const float cs = RC[pos * 16 + pi], sn = RS[pos * 16 + pi];
        const float val = (c.lane & 1) ? (pk * sn + xk[k] * cs) : (xk[k] * cs - pk * sn);
        if (c.lane < 32) KPE[(size_t)m * 32 + c.lane] = f2bf(val); }
    } }
  }
  for (int m = NT + gw; m < NT + NCTX; m += NGW) {
    const int cr = m - NT, b = cr >> 8, s = cr & 255; const size_t slot = ((size_t)(b * 2 + ic) * 256 + s);
    const f32x4 kv = *(const f32x4*)(c.in[6] + slot * 256 + 4 * c.lane);
    u32x2 w; w.x = pk2(kv[0], kv[1]); w.y = pk2(kv[2], kv[3]); *(u32x2*)(CKV + (size_t)m * 256 + 4 * c.lane) = w;
    if (c.lane < 32) KPE[(size_t)m * 32 + c.lane] = f2bf(c.in[7][slot * 32 + c.lane]);
  }
}

DI void ret_kv_item(const Ctx& c, int item, int ia) {
  const int p = item >> 3, h = item & 7;
  const bf16* Pb = (const bf16*)(c.ws + WS_BIG);
  float* KVF = (float*)(c.ws + WS_Y); float* KVB = (float*)(c.ws + WS_Y + Y_KVB);
  const float lgf2 = log_decay2(c.in[17][ia * 8 + h]), lgb2 = log_decay2(c.in[18][ia * 8 + h]);
  LAS bf16* Kn = (LAS bf16*)c.lds; LAS bf16* VF = (LAS bf16*)(c.lds + 36864); LAS bf16* VB = (LAS bf16*)(c.lds + 73728);
#pragma unroll
  for (int it = 0; it < 4; ++it) { const int q = c.tid + 512 * it, tok = q >> 3, part = q & 7;
    const bf16* rowp = Pb + (size_t)(256 * p + tok) * ACIN + h * 64 + part * 8;
    const u32x4 kk = *(const u32x4*)(rowp + 512); const u32x4 vv = *(const u32x4*)(rowp + 1024);
    const int i = tok & 127; const float df = exp2f(lgf2 * (float)(127 - i)), db = exp2f(lgb2 * (float)i);
    u32x4 vf, vb;
#pragma unroll
    for (int j = 0; j < 4; ++j) { const float v0 = bflo(vv[j]), v1 = bfhi(vv[j]); vf[j] = pk2(v0 * df, v1 * df); vb[j] = pk2(v0 * db, v1 * db); }
    *(LAS u32x4*)(Kn + tok * 72 + part * 8) = kk; *(LAS u32x4*)(VF + tok * 72 + part * 8) = vf; *(LAS u32x4*)(VB + tok * 72 + part * 8) = vb; }
  __syncthreads();
  { const int cw = c.wave >> 2, dir = (c.wave >> 1) & 1, eb = c.wave & 1, r = c.lane & 31, hh = c.lane >> 5;
    const int tq = (c.lane & 15) >> 2, tp = c.lane & 3, tblk = (c.lane >> 4) & 1;
    const LAS bf16* Vd = dir ? VB : VF;
    f32x16 a0 = zero16(), a1 = zero16();
#pragma unroll
    for (int ks = 0; ks < 8; ++ks) { const int row = cw * 128 + 16 * ks + 8 * hh + tq, col = 16 * tblk + 4 * tp;
      const bf16x8 A = cat8(tr_read(Vd + row * 72 + eb * 32 + col), tr_read(Vd + (row + 4) * 72 + eb * 32 + col));
      const bf16x8 B0 = cat8(tr_read(Kn + row * 72 + col), tr_read(Kn + (row + 4) * 72 + col));
      const bf16x8 B1 = cat8(tr_read(Kn + row * 72 + 32 + col), tr_read(Kn + (row + 4) * 72 + 32 + col));
      a0 = MFMA32(A, B0, a0); a1 = MFMA32(A, B1, a1); }
    float* dst = (dir ? KVB : KVF) + ((size_t)((2 * p + cw) * 8 + h) * 64) * 64;
#pragma unroll
    for (int reg = 0; reg < 16; ++reg) { const int e = eb * 32 + crow(reg, hh); dst[e * 64 + r] = a0[reg]; dst[e * 64 + 32 + r] = a1[reg]; } }
  __syncthreads();
}

DI void ret_out_item(const Ctx& c, int item, int ia) {
  const int p = item >> 3, h = item & 7;
  const bf16* Pb = (const bf16*)(c.ws + WS_BIG); bf16* AO = (bf16*)(c.ws + WS_H);
  const float* KVF = (const float*)(c.ws + WS_Y); const float* KVB = (const float*)(c.ws + WS_Y + Y_KVB);
  const float lgf2 = log_decay2(c.in[17][ia * 8 + h]), lgb2 = log_decay2(c.in[18][ia * 8 + h]);
  LAS bf16* Ks = (LAS bf16*)c.lds; LAS bf16* Vs = (LAS bf16*)(c.lds + 36864); LAS bf16* St = (LAS bf16*)(c.lds + 73728);
#pragma unroll
  for (int it = 0; it < 4; ++it) { const int q = c.tid + 512 * it, tok = q >> 3, part = q & 7;
    const bf16* rowp = Pb + (size_t)(256 * p + tok) * ACIN + h * 64 + part * 8;
    const u32x4 kk = *(const u32x4*)(rowp + 512); const u32x4 vv = *(const u32x4*)(rowp + 1024);
    *(LAS u32x4*)(Ks + tok * 72 + part * 8) = kk; *(LAS u32x4*)(Vs + tok * 72 + part * 8) = vv; }
  { const bool lat = p >= 32; const int b = lat ? ((p - 32) >> 3) : p; const int n0 = lat ? 2 * ((p - 32) & 7) : 0; const int N = lat ? 16 : 2; const int cbase = lat ? 64 + b * 16 : 2 * p;
    const int e = c.tid >> 3, d0 = (c.tid & 7) * 8;
    const float Gf = exp2f(lgf2 * 128.f), Gb = exp2f(lgb2 * 128.f);
    const size_t eo = (size_t)e * 64 + d0;
    float sf[8], sb[8];
    if (lat) { const float* s0f = c.in[2] + ((size_t)((b * 2 + ia) * 8 + h) * 64) * 64; const float* s0b = c.in[3] + ((size_t)((b * 2 + ia) * 8 + h) * 64) * 64;
#pragma unroll
      for (int j = 0; j < 8; ++j) { sf[j] = s0f[(d0 + j) * 64 + e]; sb[j] = s0b[(d0 + j) * 64 + e]; }
    } else {
#pragma unroll
      for (int j = 0; j < 8; ++j) { sf[j] = 0.f; sb[j] = 0.f; } }
    for (int j0 = 0; j0 < n0; j0 += 4) {
      f32x4 a[4], bq[4];
#pragma unroll
      for (int u = 0; u < 4; ++u) { const int j = min(j0 + u, n0 - 1); const float* kv = KVF + ((size_t)((cbase + j) * 8 + h) * 4096) + eo; a[u] = *(const f32x4*)kv; bq[u] = *(const f32x4*)(kv + 4); }
#pragma unroll
      for (int u = 0; u < 4; ++u) if (j0 + u < n0) {
#pragma unroll
        for (int q = 0; q < 4; ++q) { sf[q] = Gf * sf[q] + a[u][q]; sf[4 + q] = Gf * sf[4 + q] + bq[u][q]; } } }
    for (int j0 = N - 1; j0 >= n0 + 2; j0 -= 4) {
      f32x4 a[4], bq[4];
#pragma unroll
      for (int u = 0; u < 4; ++u) { const int j = max(j0 - u, n0 + 2); const float* kv = KVB + ((size_t)((cbase + j) * 8 + h) * 4096) + eo; a[u] = *(const f32x4*)kv; bq[u] = *(const f32x4*)(kv + 4); }
#pragma unroll
      for (int u = 0; u < 4; ++u) if (j0 - u >= n0 + 2) {
#pragma unroll
        for (int q = 0; q < 4; ++q) { sb[q] = Gb * sb[q] + a[u][q]; sb[4 + q] = Gb * sb[4 + q] + bq[u][q]; } } }
    { u32x4 w; w.x = pk2(sf[0], sf[1]); w.y = pk2(sf[2], sf[3]); w.z = pk2(sf[4], sf[5]); w.w = pk2(sf[6], sf[7]); *(LAS u32x4*)(St + 0 * 4608 + e * 72 + d0) = w; }
    { u32x4 w; w.x = pk2(sb[0], sb[1]); w.y = pk2(sb[2], sb[3]); w.z = pk2(sb[4], sb[5]); w.w = pk2(sb[6], sb[7]); *(LAS u32x4*)(St + 3 * 4608 + e * 72 + d0) = w; }
    { const float* kv = KVF + ((size_t)((cbase + n0) * 8 + h) * 4096) + eo; const f32x4 a = *(const f32x4*)kv, bq = *(const f32x4*)(kv + 4);
#pragma unroll
      for (int q = 0; q < 4; ++q) { sf[q] = Gf * sf[q] + a[q]; sf[4 + q] = Gf * sf[4 + q] + bq[q]; } }
    { const float* kv = KVB + ((size_t)((cbase + n0 + 1) * 8 + h) * 4096) + eo; const f32x4 a = *(const f32x4*)kv, bq = *(const f32x4*)(kv + 4);
#pragma unroll
      for (int q = 0; q < 4; ++q) { sb[q] = Gb * sb[q] + a[q]; sb[4 + q] = Gb * sb[4 + q] + bq[q]; } }
    { u32x4 w; w.x = pk2(sf[0], sf[1]); w.y = pk2(sf[2], sf[3]); w.z = pk2(sf[4], sf[5]); w.w = pk2(sf[6], sf[7]); *(LAS u32x4*)(St + 1 * 4608 + e * 72 + d0) = w; }
    { u32x4 w; w.x = pk2(sb[0], sb[1]); w.y = pk2(sb[2], sb[3]); w.z = pk2(sb[4], sb[5]); w.w = pk2(sb[6], sb[7]); *(LAS u32x4*)(St + 2 * 4608 + e * 72 + d0) = w; }
    if (!lat) {
      const float* kv1 = KVF + ((size_t)((cbase + 1) * 8 + h) * 4096) + eo; const float* kv0 = KVB + ((size_t)((cbase + 0) * 8 + h) * 4096) + eo;
      float* of = c.out + O_RF + ((size_t)((b * 2 + ia) * 8 + h) * 64) * 64; float* ob = c.out + O_RB + ((size_t)((b * 2 + ia) * 8 + h) * 64) * 64;
#pragma unroll
      for (int j = 0; j < 8; ++j) { of[(d0 + j) * 64 + e] = Gf * sf[j] + kv1[j]; ob[(d0 + j) * 64 + e] = Gb * sb[j] + kv0[j]; } }
  }
  __syncthreads();
  { const int cw = c.wave >> 2, r = c.lane & 31, hh = c.lane >> 5; const int iloc = 32 * (c.wave & 3) + r; const int m = 256 * p + 128 * cw + iloc;
    bf16x8 Qf[4];
#pragma unroll
    for (int ks = 0; ks < 4; ++ks) Qf[ks] = *(const bf16x8*)(Pb + (size_t)m * ACIN + h * 64 + 16 * ks + 8 * hh);
    f32x16 O0, O1;
    { const float decf = exp2f(lgf2 * (float)(iloc + 1)), decb = exp2f(lgb2 * (float)(128 - iloc));
      f32x16 f0 = zero16(), f1 = zero16();
      LAS bf16* SF = St + cw * 4608; LAS bf16* SB = St + (2 + cw) * 4608;
#pragma unroll
      for (int ks = 0; ks < 4; ++ks) { const int ko = 16 * ks + 8 * hh;
        f0 = MFMA32(*(const LAS bf16x8*)(SF + r * 72 + ko), Qf[ks], f0); f1 = MFMA32(*(const LAS bf16x8*)(SF + (32 + r) * 72 + ko), Qf[ks], f1); }
#pragma unroll
      for (int reg = 0; reg < 16; ++reg) { O0[reg] = decf * f0[reg]; O1[reg] = decf * f1[reg]; }
      f0 = zero16(); f1 = zero16();
#pragma unroll
      for (int ks = 0; ks < 4; ++ks) { const int ko = 16 * ks + 8 * hh;
        f0 = MFMA32(*(const LAS bf16x8*)(SB + r * 72 + ko), Qf[ks], f0); f1 = MFMA32(*(const LAS bf16x8*)(SB + (32 + r) * 72 + ko), Qf[ks], f1); }
#pragma unroll
      for (int reg = 0; reg < 16; ++reg) { O0[reg] += decb * f0[reg]; O1[reg] += decb * f1[reg]; } }
#pragma unroll 1
    for (int kb = 0; kb < 4; ++kb) {
      f32x16 s = zero16();
#pragma unroll
      for (int ks = 0; ks < 4; ++ks) { const bf16x8 A = *(const LAS bf16x8*)(Ks + (128 * cw + 32 * kb + r) * 72 + 16 * ks + 8 * hh); s = MFMA32(A, Qf[ks], s); }
#pragma unroll
      for (int reg = 0; reg < 16; ++reg) { const int diff = iloc - (32 * kb + crow(reg, hh));
        const float ex = __builtin_amdgcn_exp2f((diff > 0 ? lgf2 : -lgb2) * (float)diff);
        s[reg] *= (diff == 0) ? 2.0f : ex; }
#pragma unroll
      for (int sp = 0; sp < 2; ++sp) {
        u32x4 pw; pw.x = pk2(s[8 * sp + 0], s[8 * sp + 1]); pw.y = pk2(s[8 * sp + 2], s[8 * sp + 3]); pw.z = pk2(s[8 * sp + 4], s[8 * sp + 5]); pw.w = pk2(s[8 * sp + 6], s[8 * sp + 7]);
        const bf16x8 Pf = __builtin_bit_cast(bf16x8, pw);
        const int vrow = 128 * cw + 32 * kb + 16 * sp + 4 * hh + ((c.lane & 15) >> 2), vcol = 16 * ((c.lane >> 4) & 1) + 4 * (c.lane & 3);
        O0 = MFMA32(cat8(tr_read(Vs + vrow * 72 + vcol), tr_read(Vs + (vrow + 8) * 72 + vcol)), Pf, O0);
        O1 = MFMA32(cat8(tr_read(Vs + vrow * 72 + 32 + vcol), tr_read(Vs + (vrow + 8) * 72 + 32 + vcol)), Pf, O1);
      }
    }
    float sm = 0.f;
#pragma unroll
    for (int reg = 0; reg < 16; ++reg) sm += O0[reg] + O1[reg];
    sm += __shfl_xor(sm, 32); const float mu = sm * (1.f / 64.f);
    float vs = 0.f;
#pragma unroll
    for (int reg = 0; reg < 16; ++reg) { const float a = O0[reg] - mu, bq = O1[reg] - mu; vs += a * a + bq * bq; }
    vs += __shfl_xor(vs, 32); const float rs = 1.0f / sqrtf(vs * (1.f / 64.f) + EPS);
    const bf16* gp = Pb + (size_t)m * ACIN + 1536 + h * 64; bf16* op = AO + (size_t)m * D + h * 64;
#pragma unroll
    for (int eb = 0; eb < 2; ++eb)
#pragma unroll
      for (int g = 0; g < 4; ++g) { const int e = eb * 32 + 8 * g + 4 * hh; const u32x2 gw = *(const u32x2*)(gp + e);
        float gv[4] = {bflo(gw.x), bfhi(gw.x), bflo(gw.y), bfhi(gw.y)}; float ov[4];
#pragma unroll
        for (int j = 0; j < 4; ++j) { const float o = ((eb ? O1[4 * g + j] : O0[4 * g + j]) - mu) * rs; const float gg = gv[j]; ov[j] = o * (gg * __builtin_amdgcn_rcpf(1.f + __expf(-gg))); }
        u32x2 w; w.x = pk2(ov[0], ov[1]); w.y = pk2(ov[2], ov[3]); *(u32x2*)(op + e) = w; }
  }
  __syncthreads();
}

template <int MODE> DI void attn_item(const Ctx& c, int item, int hl) {
  constexpr int DQK = (MODE >= 2) ? 96 : 64, KS = DQK / 16, KLD = DQK + 8, VLD = 72, BUFB = 24576, VOFF = 13312;
  const int r = c.lane & 31, hh = c.lane >> 5, w = c.wave;
  const bf16* Pb = (const bf16*)(c.ws + WS_BIG);
  const bf16* KVb = (const bf16*)(c.ws + WS_BIG + BIG_KV);
  const bf16* KPE = (const bf16*)(c.ws + WS_KPE);
  const bf16* NC = (const bf16*)(c.ws + WS_NACTX);
  bf16* AO = (bf16*)(c.ws + WS_H);
  int b, h, g = 0, m, nt, nloc = 0, Rlo = 0, qr = 0, qc = 0, wsr = 0, wsc = 0;
  if (MODE == 0) { b = item >> 3; h = item & 7; m = b * 256 + 32 * w + r; nt = 4; }
  else if (MODE == 1) { b = item >> 6; h = (item >> 3) & 7; g = item & 7; qr = 4 * g + (w >> 1); qc = 32 * (w & 1) + r; m = NP + b * 2048 + qr * 64 + qc;
    Rlo = max(4 * g - 4, 0); Rlo = min(Rlo, 24); const int Rhi = min(max(4 * g - 1, 0), 24) + 7; nloc = Rhi - Rlo + 1; nt = nloc + 4;
    wsr = min(max(qr - 4, 0), 24); wsc = min(max(qc - 8, 0), 48); }
  else if (MODE == 2) { b = item >> 4; h = item & 15; m = b * 256 + 32 * w + r; nt = 4; }
  else { b = item >> 7; h = (item >> 3) & 15; g = item & 7; m = NP + b * 2048 + g * 256 + 32 * w + r; nt = 36; }
  const float sc2 = ((MODE >= 2) ? 0.10206207261596577f : 0.125f) * LOG2E;
  LAS float* rpbs = (LAS float*)(c.lds + 49152);
  if (MODE == 1) { for (int i = c.tid; i < 465; i += 512) rpbs[i] = c.in[19][(size_t)(hl * 8 + h) * 465 + i] * LOG2E; }
  bf16x8 Qf[KS]; bf16x8 Qr[2];
  if (MODE < 2) {
#pragma unroll
    for (int ks = 0; ks < KS; ++ks) Qf[ks] = *(const bf16x8*)(Pb + (size_t)m * ACIN + 2048 + h * 64 + 16 * ks + 8 * hh);
  } else {
#pragma unroll
    for (int ks = 0; ks < KS; ++ks) Qf[ks] = *(const bf16x8*)(Pb + (size_t)m * 1536 + h * 96 + 16 * ks + 8 * hh);
  }
  if (MODE == 3) { const float* RC = (const float*)(c.ws + WS_ROPE); const float* RS = RC + 32768; const int pos = g * 256 + 32 * w + r;
#pragma unroll
    for (int k2 = 0; k2 < 2; ++k2) { const f32x4 cs = *(const f32x4*)(RC + pos * 16 + 8 * k2 + 4 * hh), sn = *(const f32x4*)(RS + pos * 16 + 8 * k2 + 4 * hh);
      const u32x4 xw = __builtin_bit_cast(u32x4, Qf[4 + k2]); u32x4 ow;
#pragma unroll
      for (int q = 0; q < 4; ++q) { const float x1 = bflo(xw[q]), x2 = bfhi(xw[q]); ow[q] = pk2(x1 * cs[q] - x2 * sn[q], x1 * sn[q] + x2 * cs[q]); }
      Qr[k2] = __builtin_bit_cast(bf16x8, ow); } }
  const int skey = c.tid >> 3, spart = c.tid & 7, pkey = c.tid >> 2, ppart = c.tid & 3;
  u32x4 kreg = {0u,0u,0u,0u}, vreg = {0u,0u,0u,0u}, preg = {0u,0u,0u,0u};
#define TILE_ROW(t) ((MODE == 0 || MODE == 2) ? (b * 256 + 64 * (t)) : (MODE == 1) ? (NP + b * 2048 + (Rlo + (t)) * 64) : (((t) < 32) ? NP + b * 2048 + 64 * (t) : NT + b * 256 + 64 * ((t) - 32)))
#define LOAD_TILE(t) do { \
    if (MODE == 0 || (MODE == 1 && (t) < nloc)) { const bf16* rp_ = Pb + (size_t)(TILE_ROW(t) + skey) * ACIN + h * 64 + spart * 8; kreg = *(const u32x4*)(rp_ + 2560); vreg = *(const u32x4*)(rp_ + 3072); } \
    else if (MODE == 1) { const int tc_ = (t) - nloc; const size_t base_ = ((size_t)((hl * 2 + 0) * 8 + b) * 8 + h) * 16384 + (size_t)(64 * tc_ + skey) * 64 + spart * 8; \
      kreg = *(const u32x4*)(NC + base_); vreg = *(const u32x4*)(NC + base_ + (size_t)8 * 8 * 16384); } \
    else { const int row_ = TILE_ROW(t); const bf16* rp_ = KVb + (size_t)(row_ + skey) * 2048 + h * 64 + spart * 8; kreg = *(const u32x4*)rp_; vreg = *(const u32x4*)(rp_ + 1024); \
      if (c.tid < 256) preg = *(const u32x4*)(KPE + (size_t)(row_ + pkey) * 32 + ppart * 8); } } while (0)
#define STORE_TILE(bufi) do { \
    LAS bf16* Ks_ = (LAS bf16*)(c.lds + (bufi) * BUFB); LAS bf16* Vt_ = (LAS bf16*)(c.lds + (bufi) * BUFB + VOFF); \
    *(LAS u32x4*)(Ks_ + skey * KLD + spart * 8) = kreg; \
    if (MODE >= 2) { if (c.tid < 256) *(LAS u32x4*)(Ks_ + pkey * KLD + 64 + ppart * 8) = preg; } \
    *(LAS u32x4*)(Vt_ + skey * VLD + spart * 8) = vreg; } while (0)
  f32x16 O0 = zero16(), O1 = zero16();
  float mrun = -1e30f, lrun = 0.f;
  LOAD_TILE(0); STORE_TILE(0);
  __syncthreads();
  if (w >= 4) __builtin_amdgcn_s_setprio(1);
  for (int t = 0; t < nt; ++t) {
    if (t + 1 < nt) LOAD_TILE(t + 1);
    bool active = true; int R = 0;
    if (MODE == 1 && t < nloc) { R = Rlo + t; active = (R >= wsr) && (R < wsr + 8); }
    if (active) {
      LAS bf16* Ks = (LAS bf16*)(c.lds + (t & 1) * BUFB); LAS bf16* Vt = (LAS bf16*)(c.lds + (t & 1) * BUFB + VOFF);
      f32x16 s0 = zero16(), s1 = zero16();
      const bool rot = (MODE == 3) && (t < 32);
#pragma unroll
      for (int ks = 0; ks < KS; ++ks) { bf16x8 q = Qf[ks]; if (MODE == 3 && ks >= 4) q = rot ? Qr[ks - 4] : Qf[ks];
        const bf16x8 A0 = *(const LAS bf16x8*)(Ks + r * KLD + 16 * ks + 8 * hh); const bf16x8 A1 = *(const LAS bf16x8*)(Ks + (32 + r) * KLD + 16 * ks + 8 * hh);
        s0 = MFMA32(A0, q, s0); s1 = MFMA32(A1, q, s1); }
      float tmax = -1e30f, mnew, alpha;
      if (MODE == 1 && t < nloc) {
        const int dro = (R - qr + 7) * 31;
#pragma unroll
        for (int reg = 0; reg < 16; ++reg) { const int k0 = crow(reg, hh) - wsc, k1 = k0 + 32;
          const bool v0 = (unsigned)k0 < 16u, v1 = (unsigned)k1 < 16u;
          const int bo = dro + wsc - qc + 15;
          const float b0 = rpbs[v0 ? bo + k0 : 0], b1 = rpbs[v1 ? bo + k1 : 0];
          s0[reg] = v0 ? fmaf(s0[reg], sc2, b0) : -1e30f; s1[reg] = v1 ? fmaf(s1[reg], sc2, b1) : -1e30f;
          tmax = fmax_nc(tmax, s0[reg]); tmax = fmax_nc(tmax, s1[reg]); }
        tmax = fmaxf(tmax, __shfl_xor(tmax, 32));
        mnew = fmaxf(mrun, tmax); alpha = __builtin_amdgcn_exp2f(mrun - mnew); mrun = mnew;
#pragma unroll
        for (int reg = 0; reg < 16; ++reg) { s0[reg] = __builtin_amdgcn_exp2f(s0[reg] - mnew); s1[reg] = __builtin_amdgcn_exp2f(s1[reg] - mnew); }
      } else {
#pragma unroll
        for (int reg = 0; reg < 16; ++reg) { tmax = fmax_nc(tmax, s0[reg]); tmax = fmax_nc(tmax, s1[reg]); }
        tmax = fmaxf(tmax, __shfl_xor(tmax, 32));
        mnew = fmaxf(mrun, tmax * sc2); alpha = __builtin_amdgcn_exp2f(mrun - mnew); mrun = mnew;
#pragma unroll
        for (int reg = 0; reg < 16; ++reg) { s0[reg] = __builtin_amdgcn_exp2f(fmaf(s0[reg], sc2, -mnew)); s1[reg] = __builtin_amdgcn_exp2f(fmaf(s1[reg], sc2, -mnew)); }
      }
      float ps = 0.f;
#pragma unroll
      for (int reg = 0; reg < 16; ++reg) ps += s0[reg] + s1[reg];
      lrun = lrun * alpha + ps;
#pragma unroll
      for (int reg = 0; reg < 16; ++reg) { O0[reg] *= alpha; O1[reg] *= alpha; }
#pragma unroll
      for (int kb = 0; kb < 2; ++kb)
#pragma unroll
        for (int sp = 0; sp < 2; ++sp) {
          u32x4 pw;
          if (kb == 0) { pw.x = pk2(s0[8 * sp + 0], s0[8 * sp + 1]); pw.y = pk2(s0[8 * sp + 2], s0[8 * sp + 3]); pw.z = pk2(s0[8 * sp + 4], s0[8 * sp + 5]); pw.w = pk2(s0[8 * sp + 6], s0[8 * sp + 7]); }
          else { pw.x = pk2(s1[8 * sp + 0], s1[8 * sp + 1]); pw.y = pk2(s1[8 * sp + 2], s1[8 * sp + 3]); pw.z = pk2(s1[8 * sp + 4], s1[8 * sp + 5]); pw.w = pk2(s1[8 * sp + 6], s1[8 * sp + 7]); }
          const bf16x8 Pf = __builtin_bit_cast(bf16x8, pw);
          const int vrow = 32 * kb + 16 * sp + 4 * hh + ((c.lane & 15) >> 2), vcol = 16 * ((c.lane >> 4) & 1) + 4 * (c.lane & 3);
          O0 = MFMA32(cat8(tr_read(Vt + vrow * VLD + vcol), tr_read(Vt + (vrow + 8) * VLD + vcol)), Pf, O0);
          O1 = MFMA32(cat8(tr_read(Vt + vrow * VLD + 32 + vcol), tr_read(Vt + (vrow + 8) * VLD + 32 + vcol)), Pf, O1);
        }
    }
    if (t + 1 < nt) STORE_TILE((t + 1) & 1);
    __syncthreads();
  }
  __builtin_amdgcn_s_setprio(0);
  { const float ltot = lrun + __shfl_xor(lrun, 32); const float inv = 1.0f / ltot;
    bf16* op = AO + (size_t)m * D + ((MODE < 2) ? 512 : 0) + h * 64;
#pragma unroll
    for (int eb = 0; eb < 2; ++eb)
#pragma unroll
      for (int gq = 0; gq < 4; ++gq) { const int e = eb * 32 + 8 * gq + 4 * hh;
        u32x2 wv; if (eb == 0) { wv.x = pk2(O0[4 * gq] * inv, O0[4 * gq + 1] * inv); wv.y = pk2(O0[4 * gq + 2] * inv, O0[4 * gq + 3] * inv); }
        else { wv.x = pk2(O1[4 * gq] * inv, O1[4 * gq + 1] * inv); wv.y = pk2(O1[4 * gq + 2] * inv, O1[4 * gq + 3] * inv); }
        *(u32x2*)(op + e) = wv; } }
  __syncthreads();
}

template <int LAT> DI void mla_item(const Ctx& c, int item) {
  constexpr int KS = 6, KLD = 104, VLD = 72, KBS = 13312, VB0 = 26624, VBS = 9216;
  const int r = c.lane & 31, hh = c.lane >> 5, w = c.wave;
  const bf16* Qb = (const bf16*)(c.ws + WS_BIG); const bf16* KVb = (const bf16*)(c.ws + WS_BIG + BIG_KV); const bf16* KPE = (const bf16*)(c.ws + WS_KPE);
  bf16* AO = (bf16*)(c.ws + WS_H);
  int b, h, g = 0, m, nt;
  if (!LAT) { b = item >> 4; h = item & 15; m = b * 256 + 32 * w + r; nt = 4; }
  else { b = item >> 7; h = (item >> 3) & 15; g = item & 7; m = NP + b * 2048 + g * 256 + 32 * w + r; nt = 36; }
  const float sc2 = 0.10206207261596577f * LOG2E;
  bf16x8 Qf[4]; bf16x8 Qp[2];
  const bf16* qrow = Qb + (size_t)m * 1536 + h * 96 + 8 * hh;
#pragma unroll
  for (int ks = 0; ks < 4; ++ks) Qf[ks] = *(const bf16x8*)(qrow + 16 * ks);
#pragma unroll
  for (int k2 = 0; k2 < 2; ++k2) Qp[k2] = *(const bf16x8*)(qrow + 64 + 16 * k2);
  if (LAT) { const float* RC = (const float*)(c.ws + WS_ROPE); const float* RS = RC + 32768; const int pos = g * 256 + 32 * w + r;
#pragma unroll
    for (int k2 = 0; k2 < 2; ++k2) { const f32x4 cs = *(const f32x4*)(RC + pos * 16 + 8 * k2 + 4 * hh), sn = *(const f32x4*)(RS + pos * 16 + 8 * k2 + 4 * hh);
      const u32x4 xw = __builtin_bit_cast(u32x4, Qp[k2]); u32x4 ow;
#pragma unroll
      for (int q = 0; q < 4; ++q) { const float x1 = bflo(xw[q]), x2 = bfhi(xw[q]); ow[q] = pk2(x1 * cs[q] - x2 * sn[q], x1 * sn[q] + x2 * cs[q]); }
      Qp[k2] = __builtin_bit_cast(bf16x8, ow); } }
  const int skey = c.tid >> 3, spart = c.tid & 7, pkey = (c.tid >> 2) & 63, ppart = c.tid & 3;
  const int vq = (c.lane & 15) >> 2, vcol = 16 * ((c.lane >> 4) & 1) + 4 * (c.lane & 3);
  u32x4 kregA = {0u, 0u, 0u, 0u}, vregA = {0u, 0u, 0u, 0u}, pregA = {0u, 0u, 0u, 0u}, kregB = {0u, 0u, 0u, 0u}, vregB = {0u, 0u, 0u, 0u}, pregB = {0u, 0u, 0u, 0u};
#define MROW(t) (LAT ? (((t) < 32) ? NP + b * 2048 + 64 * (t) : NT + b * 256 + 64 * ((t) - 32)) : b * 256 + 64 * (t))
#define LOADK(S, t) do { const int row_ = MROW(t); kreg##S = *(const u32x4*)(KVb + (size_t)(row_ + skey) * 2048 + h * 64 + spart * 8); if (c.tid < 256) preg##S = *(const u32x4*)(KPE + (size_t)(row_ + pkey) * 32 + ppart * 8); } while (0)
#define LOADV(S, t) do { const int row_ = MROW(t); vreg##S = *(const u32x4*)(KVb + (size_t)(row_ + skey) * 2048 + 1024 + h * 64 + spart * 8); } while (0)
#define STOREK(S, buf) do { LAS bf16* Ks_ = (LAS bf16*)(c.lds + (buf) * KBS); *(LAS u32x4*)(Ks_ + skey * KLD + spart * 8) = kreg##S; if (c.tid < 256) *(LAS u32x4*)(Ks_ + pkey * KLD + 64 + ppart * 8) = preg##S; } while (0)
#define STOREV(S, buf) do { LAS bf16* Vs_ = (LAS bf16*)(c.lds + VB0 + (buf) * VBS); *(LAS u32x4*)(Vs_ + skey * VLD + spart * 8) = vreg##S; } while (0)
#define QKT(d0, d1, buf) do { const LAS bf16* Ks_ = (const LAS bf16*)(c.lds + (buf) * KBS); d0 = zero16(); d1 = zero16(); \
    _Pragma("unroll") for (int ks = 0; ks < KS; ++ks) { const bf16x8 q_ = (ks < 4) ? Qf[ks & 3] : Qp[ks & 1]; \
      const bf16x8 A0_ = *(const LAS bf16x8*)(Ks_ + r * KLD + 16 * ks + 8 * hh); const bf16x8 A1_ = *(const LAS bf16x8*)(Ks_ + (32 + r) * KLD + 16 * ks + 8 * hh); \
      d0 = MFMA32(A0_, q_, d0); d1 = MFMA32(A1_, q_, d1); } } while (0)
#define PVT(buf) do { const LAS bf16* Vs_ = (const LAS bf16*)(c.lds + VB0 + (buf) * VBS); \
    _Pragma("unroll") for (int f = 0; f < 4; ++f) { const bf16x8 Pf_ = __builtin_bit_cast(bf16x8, pp[f]); const int vrow_ = 16 * f + 4 * hh + vq; \
      Ls = MFMA32(ones8, Pf_, Ls); \
      O0 = MFMA32(cat8(tr_read(Vs_ + vrow_ * VLD + vcol), tr_read(Vs_ + (vrow_ + 8) * VLD + vcol)), Pf_, O0); \
      O1 = MFMA32(cat8(tr_read(Vs_ + vrow_ * VLD + 32 + vcol), tr_read(Vs_ + (vrow_ + 8) * VLD + 32 + vcol)), Pf_, O1); } } while (0)
  LOADK(A, 0); LOADV(A, 0); LOADK(B, 1);
  STOREK(A, 0); STOREV(A, 0); STOREK(B, 1);
  LOADK(B, 2); LOADV(B, 1);
  __syncthreads();
  f32x16 c0, c1;
  QKT(c0, c1, 0);
  __syncthreads();
  f32x16 O0 = zero16(), O1 = zero16(), Ls = zero16();
  const bf16x8 ones8 = {(short)0x3f80, (short)0x3f80, (short)0x3f80, (short)0x3f80, (short)0x3f80, (short)0x3f80, (short)0x3f80, (short)0x3f80};
  float mrun = -1e30f;
  int vcur = 0, vnext = 1;
#define MLA_ITER(SL, SS) do { \
    { const int tk = min(t + 3, nt - 1), tv = min(t + 2, nt - 1); LOADK(SL, tk); LOADV(SL, tv); } \
    if (LAT && t + 1 == 32) { _Pragma("unroll") for (int k2 = 0; k2 < 2; ++k2) Qp[k2] = *(const bf16x8*)(qrow + 64 + 16 * k2); } \
    float tmax = -1e30f; \
    _Pragma("unroll") for (int reg = 0; reg < 16; ++reg) { tmax = fmax_nc(tmax, c0[reg]); tmax = fmax_nc(tmax, c1[reg]); } \
    tmax = fmaxf(tmax, __shfl_xor(tmax, 32)); \
    const float tm = tmax * sc2; \
    if (__builtin_amdgcn_ballot_w64(tm > mrun + 8.0f) != 0ull) { \
      const float mnew = fmaxf(mrun, tm); const float alpha = __builtin_amdgcn_exp2f(mrun - mnew); mrun = mnew; \
      _Pragma("unroll") for (int reg = 0; reg < 16; ++reg) { O0[reg] *= alpha; O1[reg] *= alpha; Ls[reg] *= alpha; } } \
    f32x16 n0, n1; \
    QKT(n0, n1, (t + 1) & 1); \
    _Pragma("unroll") for (int reg = 0; reg < 16; ++reg) { c0[reg] = __builtin_amdgcn_exp2f(fmaf(c0[reg], sc2, -mrun)); c1[reg] = __builtin_amdgcn_exp2f(fmaf(c1[reg], sc2, -mrun)); } \
    u32x4 pp[4]; \
    _Pragma("unroll") for (int sp = 0; sp < 2; ++sp) { \
      pp[sp] = (u32x4){pk2(c0[8 * sp + 0], c0[8 * sp + 1]), pk2(c0[8 * sp + 2], c0[8 * sp + 3]), pk2(c0[8 * sp + 4], c0[8 * sp + 5]), pk2(c0[8 * sp + 6], c0[8 * sp + 7])}; \
      pp[2 + sp] = (u32x4){pk2(c1[8 * sp + 0], c1[8 * sp + 1]), pk2(c1[8 * sp + 2], c1[8 * sp + 3]), pk2(c1[8 * sp + 4], c1[8 * sp + 5]), pk2(c1[8 * sp + 6], c1[8 * sp + 7])}; } \
    PVT(vcur); \
    c0 = n0; c1 = n1; \
    STOREK(SS, t & 1); STOREV(SS, vnext); \
    { const int nv = (vnext == 2) ? 0 : vnext + 1; vcur = vnext; vnext = nv; } \
    __syncthreads(); } while (0)
  if (w >= 4) __builtin_amdgcn_s_setprio(1);
  for (int t = 0; t < nt; t += 2) {
    MLA_ITER(A, B);
    ++t;
    MLA_ITER(B, A);
    --t;
  }
#undef MLA_ITER
  __builtin_amdgcn_s_setprio(0);
  { const float inv = 1.0f / Ls[0];
    bf16* op = AO + (size_t)m * D + h * 64;
#pragma unroll
    for (int eb = 0; eb < 2; ++eb)
#pragma unroll
      for (int gq = 0; gq < 4; ++gq) { const int e = eb * 32 + 8 * gq + 4 * hh;
        u32x2 wv; if (eb == 0) { wv.x = pk2(O0[4 * gq] * inv, O0[4 * gq + 1] * inv); wv.y = pk2(O0[4 * gq + 2] * inv, O0[4 * gq + 3] * inv); }
        else { wv.x = pk2(O1[4 * gq] * inv, O1[4 * gq + 1] * inv); wv.y = pk2(O1[4 * gq + 2] * inv, O1[4 * gq + 3] * inv); }
        *(u32x2*)(op + e) = wv; } }
  __syncthreads();
#undef MROW
#undef LOADK
#undef LOADV
#undef STOREK
#undef STOREV
#undef QKT
#undef PVT
}

#define XB_TMO      128
#define XB_XCNT(j)  (256  + 64 * (j))
#define XB_XSUB(j)  (1280 + 64 * (j))
#define XB_XGEN(j)  (2304 + 64 * (j))
#define XB_TOP      3328
#define XB_TOPGEN   3392
#define XCD_BAR_WORDS 3456
#define XB_SPIN_CAP (1u << 18)
DI unsigned xb_ld(unsigned* p)              { return __hip_atomic_load(p, __ATOMIC_RELAXED, __HIP_MEMORY_SCOPE_AGENT); }
DI unsigned xb_add(unsigned* p, unsigned v) { return __hip_atomic_fetch_add(p, v, __ATOMIC_RELAXED, __HIP_MEMORY_SCOPE_AGENT); }
DI unsigned xb_xcc_id() { return (unsigned)__builtin_amdgcn_s_getreg((3 << 11) | 20) & 0xFu; }
#define XB_SPIN(cond, bar) do { unsigned _sp = 0; while (cond) { __builtin_amdgcn_s_sleep(1); \
    if ((++_sp & 255u) == 0u) { if (xb_ld(&(bar)[XB_TMO])) break; if (_sp > XB_SPIN_CAP) { atomicAdd(&(bar)[XB_TMO], 1u); break; } } } } while (0)
struct XcdBarrier { unsigned* bar; unsigned x; volatile LAS unsigned* st; };
DI void xcd_barrier_post(unsigned* bar) { if (threadIdx.x == 0) (void)xb_add(&bar[XB_XCNT(xb_xcc_id())], 1u); }
DI void xcd_barrier_complete(unsigned* bar, unsigned x, unsigned& nloc, unsigned& nx) {
  const unsigned G = gridDim.x * gridDim.y * gridDim.z;
  unsigned sum, cnt, mine, sp = 0u;
  for (;;) {
    sum = 0u; cnt = 0u; mine = 0u;
#pragma unroll
    for (unsigned j = 0; j < 16; ++j) { const unsigned c = xb_ld(&bar[XB_XCNT(j)]); sum += c; cnt += (c > 0u) ? 1u : 0u; mine = (j == x) ? c : mine; }
    if (sum == G) break;
    __builtin_amdgcn_s_sleep(1);
    if ((++sp & 255u) == 0u) { if (xb_ld(&bar[XB_TMO])) break; if (sp > XB_SPIN_CAP) { atomicAdd(&bar[XB_TMO], 1u); break; } }
  }
  nloc = mine > 0u ? mine : 1u; nx = cnt > 0u ? cnt : 1u;
}
DI void xcd_barrier(const XcdBarrier& b) {
  asm volatile("s_waitcnt vmcnt(0)" ::: "memory");
  __syncthreads();
  if (threadIdx.x == 0) {
    unsigned* bar = b.bar;
    __builtin_amdgcn_s_waitcnt(0);
    unsigned nloc = b.st[0], nx = b.st[1];
    if (nloc == 0u) { xcd_barrier_complete(bar, b.x, nloc, nx); b.st[0] = nloc; b.st[1] = nx; }
    const unsigned old = xb_add(&bar[XB_XSUB(b.x)], 1u);
    const unsigned gen = old / nloc;
    if (old + 1u == (gen + 1u) * nloc) {
      __builtin_amdgcn_fence(__ATOMIC_RELEASE, "agent");
      asm volatile("s_waitcnt vmcnt(0)" ::: "memory");
      const unsigned og = xb_add(&bar[XB_TOP], 1u);
      const unsigned tg = og / nx;
      if (og + 1u == (tg + 1u) * nx) xb_add(&bar[XB_TOPGEN], 1u);
      else XB_SPIN(xb_ld(&bar[XB_TOPGEN]) == tg, bar);
      __builtin_amdgcn_fence(__ATOMIC_ACQUIRE, "agent");
      xb_add(&bar[XB_XGEN(b.x)], 1u);
      asm volatile("s_waitcnt vmcnt(0)" ::: "memory");
    } else {
      XB_SPIN(xb_ld(&bar[XB_XGEN(b.x)]) == gen, bar);
      __builtin_amdgcn_fence(__ATOMIC_ACQUIRE, "agent");
      asm volatile("s_waitcnt vmcnt(0)" ::: "memory");
    }
  }
  __syncthreads();
}
constexpr size_t WS_BAR = 65536;
constexpr int LDS_BARST = 139264;

#ifdef PROBE_MASK
#define TICK(slot) do { if (blockIdx.x == 0 && threadIdx.x == 0) { volatile unsigned long long* tw_ = (volatile unsigned long long*)a.ws; const unsigned long long now_ = __builtin_amdgcn_s_memrealtime(); \
    if ((PROBE_MASK >> (slot)) & 1) tw_[1] = tw_[1] + (now_ - tw_[0]); tw_[0] = now_; } } while (0)
#else
#define TICK(slot) do { } while (0)
#endif
#define RFL64(p) (((unsigned long long)(unsigned)__builtin_amdgcn_readfirstlane((int)((unsigned long long)(p) >> 32)) << 32) | (unsigned long long)(unsigned)__builtin_amdgcn_readfirstlane((int)(unsigned)(unsigned long long)(p)))
#define XSYNC1() do { XcdBarrier xb_; { unsigned long long bp_ = RFL64(a.ws + WS_BAR); asm volatile("" : "+s"(bp_)); xb_.bar = (unsigned*)(__attribute__((address_space(1))) unsigned*)bp_; } xb_.x = xb_xcc_id(); xb_.st = (volatile LAS unsigned*)((lptr)lds_raw + LDS_BARST); xcd_barrier(xb_); } while (0)
#ifdef DOUBLE_SYNC
#define GSYNC() do { XSYNC1(); XSYNC1(); } while (0)
#else
#define GSYNC() XSYNC1()
#endif
__global__ void __launch_bounds__(512, 2) mk_fwd(Args a) {
  extern __shared__ __attribute__((aligned(16))) unsigned char lds_raw[];
  cg::grid_group grid = cg::this_grid();
  const int wave0 = __builtin_amdgcn_readfirstlane((int)(threadIdx.x >> 6));
#define MAKE_CTX() Ctx c; { unsigned long long wsp_ = RFL64(a.ws), outp_ = RFL64(a.out); int z_ = 0; int lane_; int g_ = __builtin_amdgcn_readfirstlane((int)gridDim.x), b_ = __builtin_amdgcn_readfirstlane((int)blockIdx.x); \
    asm volatile("v_mbcnt_lo_u32_b32 %0, -1, 0\n\tv_mbcnt_hi_u32_b32 %0, -1, %0" : "=v"(lane_)); \
    asm volatile("" : "+s"(wsp_), "+s"(outp_), "+s"(z_), "+s"(g_), "+s"(b_)); const int tid_ = wave0 * 64 + lane_; \
    c.in = a.in + z_; c.out = (float*)(__attribute__((address_space(1))) float*)outp_; c.ws = (unsigned char*)(__attribute__((address_space(1))) unsigned char*)wsp_; c.lds = (lptr)lds_raw; c.tid = tid_; c.lane = lane_; c.wave = wave0; c.G = g_; c.bid = b_; c.zero = z_; } \
    unsigned char* ws = c.ws; bf16* Hb = (bf16*)(ws + WS_H); float* Yb = (float*)(ws + WS_Y); unsigned char* BIG = ws + WS_BIG; unsigned char* WA = ws + WS_WA; (void)Hb; (void)Yb; (void)BIG; (void)WA;
  if (threadIdx.x < 4) ((LAS unsigned*)((lptr)lds_raw + LDS_BARST))[threadIdx.x] = 0u;
  __syncthreads();
  xcd_barrier_post((unsigned*)(a.ws + WS_BAR));
#ifdef PROBE_MASK
  if (blockIdx.x == 0 && threadIdx.x == 0) { volatile unsigned long long* tw_ = (volatile unsigned long long*)a.ws; tw_[1] = 0ull; tw_[0] = __builtin_amdgcn_s_memrealtime(); }
#endif
#if !defined(PHASE_MASK) || (PHASE_MASK & 1)
  { MAKE_CTX(); prologue(c); }
  if (a.use_cg) grid.sync(); else GSYNC();
  { MAKE_CTX(); row_phase(c, 0, 0); }
  GSYNC();
  TICK(0);
#endif

  for (int l = 0; l < 4; ++l) {
    const int odd = l & 1, hl = l >> 1;
    const unsigned long long prog = odd ? 0x7C65BA984ull : 0x7C65B321ull;
    for (int st = 0; st < 9; ++st) {
      const int op = (int)((prog >> (4 * st)) & 15ull);
      if (op == 0) break;
#ifdef PHASE_MASK
      if (!((PHASE_MASK >> op) & 1)) continue;
#endif
      if (op == 1) { MAKE_CTX();
        pg8::Gemm g{Hb, (const bf16*)WA, NT, ACIN, D, D, D, ACIN / 256}; pg8::StaticOrder S; S.init(NT, ACIN, c.G, c.bid);
        pg8::EpiBf16<2> E{(bf16*)BIG, ACIN, c.out + O_NK + (size_t)hl * 8 * 256 * 64, c.out + O_NV + (size_t)hl * 8 * 256 * 64};
        pg8::gemm_phase(c.lds, g, S, E, c.tid);
      } else if (op == 2) { MAKE_CTX();
        const int vb = (c.G % 8 == 0) ? (c.bid % 8) * (c.G / 8) + c.bid / 8 : c.bid;
        for (int it = vb; it < 768 + 256 + 512; it += c.G) {
          if (it < 768) ret_kv_item(c, it, hl);
          else if (it < 1024) attn_item<0>(c, it - 768, hl);
          else attn_item<1>(c, it - 1024, hl);
        }
      } else if (op == 3) { MAKE_CTX();
        const int vb = (c.G % 8 == 0) ? (c.bid % 8) * (c.G / 8) + c.bid / 8 : c.bid;
        for (int it = vb; it < 768; it += c.G) ret_out_item(c, it, hl);
      } else if (op == 4) { MAKE_CTX();
        pg8::Gemm g{Hb, (const bf16*)WA, NT, CINP, D, D, D, CINP / 256}; pg8::EpiF32 E{(float*)BIG, CINP};
        pg8::StaticOrder S; S.init(g.M, g.N, c.G, c.bid);
        pg8::gemm_phase(c.lds, g, S, E, c.tid);
      } else if (op == 5) { MAKE_CTX();
        row_phase(c, l, 1);
      } else if (op == 6) { MAKE_CTX();
        pg8::Gemm g{Hb, (const bf16*)(ws + WS_W1T), NT, FF, D, D, D, FF / 256}; pg8::StaticOrder S; S.init(NT, FF, c.G, c.bid);
        pg8::EpiBf16<1> E{(bf16*)BIG, FF, nullptr, nullptr};
        pg8::gemm_phase(c.lds, g, S, E, c.tid);
      } else if (op == 7) { MAKE_CTX();
        row_phase(c, l, 2);
        if (l < 3) convert_weights(c, l + 1);
      } else if (op == 8) { MAKE_CTX();
        mla_rows(c, hl);
      } else if (op == 9 || op == 11 || op == 12) { MAKE_CTX();
        const int njobs = (op == 9) ? 2 : 1;
        for (int j = 0; j < njobs; ++j) {
          pg8::Gemm g; pg8::EpiBf16<0> E;
          if (op == 9) {
            if (j) { g = pg8::Gemm{(const bf16*)(ws + WS_H + H_CKVN), (const bf16*)(WA + WA_UKV), NT + NCTX, 2048, 256, 256, 256, 8}; E = pg8::EpiBf16<0>{(bf16*)(BIG + BIG_KV), 2048, nullptr, nullptr}; }
            else { g = pg8::Gemm{Hb, (const bf16*)(WA + WA_UQ), NT, 1536, 384, 384, 384, 6}; E = pg8::EpiBf16<0>{(bf16*)BIG, 1536, nullptr, nullptr}; }
          } else if (op == 11) { g = pg8::Gemm{Hb, (const bf16*)(WA + (odd ? WA_OUT_O : WA_OUT_E)), NT, D, D, D, D, 4}; E = pg8::EpiBf16<0>{(bf16*)Yb, D, nullptr, nullptr};
          } else { g = pg8::Gemm{(const bf16*)BIG, (const bf16*)(ws + WS_W2T), NT, 2 * D, FF / 2, FF, FF, 4}; E = pg8::EpiBf16<0>{(bf16*)Yb, 2 * D, nullptr, nullptr}; }
          pg8::StaticOrder S; S.init(g.M, g.N, c.G, (op == 9 && j) ? (c.bid + 3 * c.G / 4) % c.G : c.bid);
          pg8::gemm_phase(c.lds, g, S, E, c.tid);
        }
      } else if (op == 10) { MAKE_CTX();
        const int vb = (c.G % 8 == 0) ? (c.bid % 8) * (c.G / 8) + c.bid / 8 : c.bid;
        for (int it = vb; it < 512 + 1024; it += c.G) {
          if (it < 512) mla_item<0>(c, it); else mla_item<1>(c, it - 512);
        }
      }
      GSYNC();
      TICK(op);
    }
  }
#ifdef PROBE_MASK
  if (blockIdx.x == 0 && threadIdx.x == 0) { volatile unsigned long long* tw_ = (volatile unsigned long long*)a.ws; const unsigned long long wait_ = tw_[1] * 10ull, t0_ = __builtin_amdgcn_s_memrealtime();
    while (__builtin_amdgcn_s_memrealtime() - t0_ < wait_) __builtin_amdgcn_s_sleep(8); }
#endif
}

extern "C" void kernel_launch(void* const* d_in, const int* in_sizes, int n_in, void* d_out, int out_size, void* d_ws, size_t ws_size, hipStream_t stream) {
  static int grid = 0;
  if (grid == 0) {
    if (n_in != 27 || out_size != 50855936 || ws_size < WS_END) { fprintf(stderr, "kernel_launch: unexpected shapes (n_in %d out %d ws %zu)\n", n_in, out_size, ws_size); grid = -1; return; }
    int dev = 0, cus = 0, per_cu = 0;
    if (hipGetDevice(&dev) != hipSuccess || hipDeviceGetAttribute(&cus, hipDeviceAttributeMultiprocessorCount, dev) != hipSuccess) { grid = -1; return; }
    if (hipFuncSetAttribute((const void*)mk_fwd, hipFuncAttributeMaxDynamicSharedMemorySize, LDS_BYTES) != hipSuccess) { fprintf(stderr, "kernel_launch: hipFuncSetAttribute failed\n"); grid = -1; return; }
    if (hipOccupancyMaxActiveBlocksPerMultiprocessor(&per_cu, (const void*)mk_fwd, 512, LDS_BYTES) != hipSuccess || per_cu < 1) { fprintf(stderr, "kernel_launch: occupancy query says %d\n", per_cu); per_cu = 1; }
    (void)hipGetLastError();
    grid = cus;
  }
  if (grid < 0) return;
  Args a{};
  for (int i = 0; i < 27; ++i) a.in[i] = (const float*)d_in[i];
  a.out = (float*)d_out; a.ws = (unsigned char*)d_ws;
  if (hipMemsetAsync((char*)d_ws + WS_BAR, 0, 16384, stream) != hipSuccess) { fprintf(stderr, "kernel_launch: memset failed\n"); return; }
  void* args[] = {&a};
  hipError_t e = hipLaunchCooperativeKernel((const void*)mk_fwd, dim3(grid), dim3(512), args, LDS_BYTES, stream);
  if (e != hipSuccess) fprintf(stderr, "kernel_launch: cooperative launch failed: %s\n", hipGetErrorString(e));
}
```

```cpp
#include <hip/hip_runtime.h>
#include <hip/hip_cooperative_groups.h>
#include <cstdio>
namespace cg = cooperative_groups;

#define DI __device__ __forceinline__
#define LAS __attribute__((address_space(3)))
typedef unsigned short bf16;
typedef short bf16x8 __attribute__((ext_vector_type(8)));
typedef short s16x4 __attribute__((ext_vector_type(4)));
typedef float f32x4 __attribute__((ext_vector_type(4)));
typedef float f32x2 __attribute__((ext_vector_type(2)));
typedef float f32x16 __attribute__((ext_vector_type(16)));
typedef unsigned u32x4 __attribute__((ext_vector_type(4)));
typedef unsigned u32x2 __attribute__((ext_vector_type(2)));
typedef __bf16 bf16x2_t __attribute__((ext_vector_type(2)));
typedef LAS unsigned char* lptr;

#define LDS_WAIT() asm volatile("s_waitcnt lgkmcnt(0)" ::: "memory")
#define MFMA32(a, b, c) __builtin_amdgcn_mfma_f32_32x32x16_bf16((a), (b), (c), 0, 0, 0)

DI unsigned pk2(float lo, float hi) { f32x2 v = {lo, hi}; bf16x2_t b = __builtin_convertvector(v, bf16x2_t); return __builtin_bit_cast(unsigned, b); }
DI bf16 f2bf(float f) { return (bf16)(pk2(f, 0.f) & 0xffffu); }
DI float bf2f(unsigned b) { return __builtin_bit_cast(float, (b & 0xffffu) << 16); }
DI float bflo(unsigned w) { return __builtin_bit_cast(float, w << 16); }
DI float bfhi(unsigned w) { return __builtin_bit_cast(float, w & 0xffff0000u); }
DI float wave_sum(float v) {
#pragma unroll
  for (int o = 1; o < 64; o <<= 1) v += __shfl_xor(v, o);
  return v;
}
DI s16x4 tr_read(const LAS bf16* p) { return __builtin_amdgcn_ds_read_tr16_b64_v4i16((LAS s16x4*)p); }
DI bf16x8 cat8(s16x4 lo, s16x4 hi) { return __builtin_shufflevector(lo, hi, 0, 1, 2, 3, 4, 5, 6, 7); }
DI float fmax_nc(float a, float b) { return __builtin_amdgcn_fmed3f(a, b, __builtin_inff()); }
DI int crow(int reg, int h) { return (reg & 3) + 8 * (reg >> 2) + 4 * h; }
DI f32x16 zero16() { f32x16 z; for (int i = 0; i < 16; ++i) z[i] = 0.f; return z; }

constexpr int D = 1024, NP = 8192, NS = 16384, NT = 24576, FF = 4096, ACIN = 3584, CINP = 768, NCTX = 2048;
constexpr float EPS = 1e-6f, LOG2E = 1.4426950408889634f;
constexpr size_t O_RF = 25165824, O_RB = 27262976, O_NK = 29360128, O_NV = 37748736, O_CKV = 46137344, O_KPE = 50331648;
constexpr size_t MiB = 1u << 20;
constexpr size_t WS_MOD = 1 * MiB, WS_ROPE = 2 * MiB, WS_KPE = 3 * MiB, WS_NACTX = 5 * MiB;
constexpr size_t WS_W1T = 13 * MiB, WS_W2T = 21 * MiB, WS_WA = 29 * MiB;
constexpr size_t WS_H = 40 * MiB, WS_Y = 88 * MiB, WS_BIG = 184 * MiB, WS_END = 376 * MiB;
constexpr size_t WA_OUT_E = 7 * MiB, WA_UQ = 1536 * 1024, WA_UKV = 3 * MiB, WA_OUT_O = 4 * MiB;
constexpr size_t H_CKVN = 20 * MiB;
constexpr size_t Y_KVB = 24 * MiB;
constexpr size_t BIG_KV = 72 * MiB;
constexpr int LDS_BYTES = 147456;

struct Args { const float* in[27]; float* out; unsigned char* ws; unsigned long long use_cg; };

namespace pg8 {
constexpr int BM = 256, BK = 64, HALF = 128, HTB = HALF * BK * 2, NXCD = 8, WGM = 8;
DI int lds_byte(int r, int c) { const int st = (r >> 4) * 2 + (c >> 5), rr = r & 15, cc = c & 31, ob = rr * 64 + cc * 2; return st * 1024 + (ob ^ (((ob >> 9) & 1) << 5)); }
DI void stage_rc(int b, int& R, int& C) { const int st = b / 1024, sb = b % 1024, swz = sb ^ (((sb >> 9) & 1) << 5); R = (st >> 1) * 16 + swz / 64; C = (st & 1) * 32 + (swz % 64) / 2; }
DI int perm32(int rho) { const int n = rho >> 4, i = rho & 15; return 8 * (i >> 2) + 4 * n + (i & 3); }
struct Unit { int pm, pn; };
struct Gemm { const bf16* A; const bf16* Bt; int M, N, K, lda, ldb, nNreal; };
struct StaticOrder {
  int nM, nN, nwg, G, c;
  DI void init(int M, int N, int G_, int c_) { nM = M / BM; nN = N / BM; nwg = nM * nN; G = G_; c = c_; }
  DI bool next(int i, Unit& u) const {
    const long L = (long)i * G + c; if (L >= nwg) return false;
    int wgid = (int)L; { const int q = nwg / NXCD, r = nwg % NXCD, xcd = wgid % NXCD, off = wgid / NXCD; wgid = (xcd < r ? xcd * (q + 1) : r * (q + 1) + (xcd - r) * q) + off; }
    const int nig = WGM * nN, gid = wgid / nig, fm = gid * WGM, gsz = (nM - fm) < WGM ? (nM - fm) : WGM;
    u.pm = fm + ((wgid % nig) % gsz); u.pn = (wgid % nig) / gsz; return true;
  }
};
struct EpiF32 {
  static constexpr bool PERM = false;
  float* C; int ldc;
  DI void operator()(const f32x4 (&acc)[2][2][4][2], const Unit& u, int wr, int wc, int fr, int fq) const {
    const int row0 = u.pm * BM + wr * 64 + fr, col0 = u.pn * BM + wc * 32 + 4 * fq;
#pragma unroll
    for (int ai = 0; ai < 2; ++ai)
#pragma unroll
      for (int m = 0; m < 4; ++m) { float* rowp = C + (size_t)(row0 + ai * HALF + m * 16) * ldc + col0;
#pragma unroll
        for (int bj = 0; bj < 2; ++bj)
#pragma unroll
          for (int n = 0; n < 2; ++n) *(f32x4*)(rowp + bj * HALF + n * 16) = acc[ai][bj][m][n]; }
  }
};
template <int MODE> struct EpiBf16 {
  static constexpr bool PERM = true;
  bf16* O; int ldc; float* nk_out; float* nv_out;
  DI void operator()(const f32x4 (&acc)[2][2][4][2], const Unit& u, int wr, int wc, int fr, int fq) const {
    const int row0 = u.pm * BM + wr * 64 + fr; const int col0 = u.pn * BM + wc * 32 + 8 * fq;
    const float sc = (MODE == 2 && (u.pn == 2 || u.pn == 3)) ? 0.125f : 1.0f;
    const bool side = (MODE == 2) && (u.pn >= 10) && (u.pm < 32);
    float* sbase = (u.pn >= 12) ? nv_out : nk_out;
    const int scol0 = col0 - ((u.pn >= 12) ? 3072 : 2560);
#pragma unroll
    for (int ai = 0; ai < 2; ++ai)
#pragma unroll
      for (int m = 0; m < 4; ++m) { const int row = row0 + ai * HALF + m * 16; bf16* rowp = O + (size_t)row * ldc + col0;
#pragma unroll
        for (int bj = 0; bj < 2; ++bj) { f32x4 v0 = acc[ai][bj][m][0], v1 = acc[ai][bj][m][1];
          if (MODE == 1) {
#pragma unroll
            for (int j = 0; j < 4; ++j) { float a = fmaxf(v0[j], 0.f), b = fmaxf(v1[j], 0.f); v0[j] = a * a; v1[j] = b * b; } }
          if (MODE == 2) { v0 = v0 * sc; v1 = v1 * sc; }
          u32x4 w; w.x = pk2(v0[0], v0[1]); w.y = pk2(v0[2], v0[3]); w.z = pk2(v1[0], v1[1]); w.w = pk2(v1[2], v1[3]);
          *(u32x4*)(rowp + bj * HALF) = w;
          if (MODE == 2) { if (side) { const int cc = scol0 + bj * HALF; const int hh = cc >> 6, dd = cc & 63; const int b = row >> 8, s = row & 255;
              float* dst = sbase + ((size_t)((b * 2) * 8 + hh) * 256 + s) * 64 + dd;
              *(f32x4*)dst = v0; *(f32x4*)(dst + 4) = v1; } }
        } }
  }
};

template <class Epi>
DI void gemm_phase(lptr lds, const Gemm g, const StaticOrder& S, const Epi& E, const int tid) {
  const int wid = __builtin_amdgcn_readfirstlane(tid >> 6), lane = tid & 63, wr = wid >> 2, wc = wid & 3, fr = lane & 15, fq = lane >> 4;
  const int K = g.K, nt = K / BK;
  unsigned voffA[2], voffB[2];
#pragma unroll
  for (int i = 0; i < 2; ++i) { int R, C; stage_rc(tid * 16 + i * 8192, R, C); const int Rb = Epi::PERM ? ((R & ~31) + perm32(R & 31)) : R;
    voffA[i] = (unsigned)(R * g.lda + C) * 2u; voffB[i] = (unsigned)(Rb * g.ldb + C) * 2u; }
  const size_t kstep = (size_t)(BK * 2);
  const size_t hstepA = (size_t)HALF * g.lda * 2, hstepB = (size_t)HALF * g.ldb * 2;
  const size_t tstepA = 2 * hstepA, tstepB = 2 * hstepB; const int nNr = g.nNreal; const size_t ksl = (size_t)K * 2;
  const unsigned ldsw = (unsigned)wid * 1024u;
  const int aoff = lds_byte(wr * 64 + fr, fq * 8), boff = lds_byte(wc * 32 + fr, fq * 8);
#define PG8_SA(b, h) (((b) * 2 + (h)) * HTB)
#define PG8_SB(b, h) ((4 + (b) * 2 + (h)) * HTB)
#define PG8_STAGE(bufoff, gbase, voff) do { _Pragma("unroll") for (int _i = 0; _i < 2; ++_i) \
    __builtin_amdgcn_global_load_lds((const unsigned*)((const char*)(gbase) + (voff)[_i]), (LAS unsigned*)(lds + (bufoff) + ldsw + _i * 8192), 16, 0, 0); } while (0)
#define PG8_LDA(dst, b, h) do { _Pragma("unroll") for (int m = 0; m < 4; ++m) _Pragma("unroll") for (int k = 0; k < 2; ++k) dst[m][k] = *(const LAS bf16x8*)(lds + PG8_SA(b, h) + aoff + m * 2048 + k * 1024); } while (0)
#define PG8_LDB(dst, b, h) do { _Pragma("unroll") for (int n = 0; n < 2; ++n) _Pragma("unroll") for (int k = 0; k < 2; ++k) dst[n][k] = *(const LAS bf16x8*)(lds + PG8_SB(b, h) + boff + n * 2048 + k * 1024); } while (0)
#define PG8_MMA(ai, bj, At, Bt) do { __builtin_amdgcn_s_setprio(1); _Pragma("unroll") for (int m = 0; m < 4; ++m) _Pragma("unroll") for (int n = 0; n < 2; ++n) _Pragma("unroll") for (int k = 0; k < 2; ++k) \
    acc[ai][bj][m][n] = __builtin_amdgcn_mfma_f32_16x16x32_bf16(Bt[n][k], At[m][k], acc[ai][bj][m][n], 0, 0, 0); __builtin_amdgcn_s_setprio(0); } while (0)
#define PG8_WAIT_V(n) asm volatile("s_waitcnt vmcnt(" #n ")" ::: "memory")
#define PG8_WAIT_L(n) asm volatile("s_waitcnt lgkmcnt(" #n ")" ::: "memory")
#define PG8_BAR __builtin_amdgcn_s_barrier()
#define PG8_SCHED __builtin_amdgcn_sched_barrier(0)
  Unit cur, nxt; int ui = 0;
  if (!S.next(0, cur)) return;
  f32x4 acc[2][2][4][2];
#pragma unroll
  for (int a = 0; a < 2; ++a)
#pragma unroll
    for (int b = 0; b < 2; ++b)
#pragma unroll
      for (int m = 0; m < 4; ++m)
#pragma unroll
        for (int n = 0; n < 2; ++n) acc[a][b][m][n] = (f32x4){0.f, 0.f, 0.f, 0.f};
  bf16x8 At[4][2], B0[2][2], B1[2][2];
  const char* cA = (const char*)g.A + (size_t)cur.pm * tstepA + (size_t)(cur.pn / nNr) * ksl; const char* cB = (const char*)g.Bt + (size_t)(cur.pn % nNr) * tstepB + (size_t)(cur.pn / nNr) * ksl;
  PG8_STAGE(PG8_SB(0, 0), cB, voffB); PG8_STAGE(PG8_SA(0, 0), cA, voffA); PG8_STAGE(PG8_SB(0, 1), cB + hstepB, voffB); PG8_STAGE(PG8_SA(0, 1), cA + hstepA, voffA);
  if (wr == 1) PG8_BAR;
  PG8_WAIT_V(4); PG8_BAR;
  PG8_STAGE(PG8_SB(1, 0), cB + kstep, voffB); PG8_STAGE(PG8_SA(1, 0), cA + kstep, voffA); PG8_STAGE(PG8_SB(1, 1), cB + hstepB + kstep, voffB);
  PG8_WAIT_V(6); PG8_BAR;
  for (;;) {
    const bool has_next = S.next(ui + 1, nxt);
    const char* nA = has_next ? (const char*)g.A + (size_t)nxt.pm * tstepA + (size_t)(nxt.pn / nNr) * ksl : cA; const char* nB = has_next ? (const char*)g.Bt + (size_t)(nxt.pn % nNr) * tstepB + (size_t)(nxt.pn / nNr) * ksl : cB;
    for (int t = 0; t < nt; t += 2) {
      const bool last = (t == nt - 2);
      const char* a1 = cA + (size_t)(t + 1) * kstep;
      const char* a2 = last ? nA : cA + (size_t)(t + 2) * kstep; const char* b2 = last ? nB : cB + (size_t)(t + 2) * kstep;
      const char* a3 = a2 + kstep; const char* b3 = b2 + kstep;
      PG8_LDB(B0, 0, 0); PG8_SCHED; PG8_LDA(At, 0, 0); PG8_STAGE(PG8_SA(1, 1), a1 + hstepA, voffA);
      PG8_WAIT_L(8); PG8_BAR; PG8_WAIT_L(0); PG8_MMA(0, 0, At, B0); PG8_BAR; PG8_SCHED;
      PG8_LDB(B1, 0, 1); PG8_STAGE(PG8_SB(0, 0), b2, voffB);
      PG8_BAR; PG8_WAIT_L(0); PG8_MMA(0, 1, At, B1); PG8_BAR;
      PG8_LDA(At, 0, 1); PG8_STAGE(PG8_SA(0, 0), a2, voffA);
      PG8_BAR; PG8_WAIT_L(0); PG8_MMA(1, 0, At, B0); PG8_BAR; PG8_SCHED;
      PG8_STAGE(PG8_SB(0, 1), b2 + hstepB, voffB);
      PG8_WAIT_V(6); PG8_BAR; PG8_MMA(1, 1, At, B1); PG8_BAR;
      PG8_LDB(B0, 1, 0); PG8_SCHED; PG8_LDA(At, 1, 0); PG8_STAGE(PG8_SA(0, 1), a2 + hstepA, voffA);
      PG8_WAIT_L(8); PG8_BAR; PG8_WAIT_L(0); PG8_MMA(0, 0, At, B0); PG8_BAR; PG8_SCHED;
      PG8_LDB(B1, 1, 1); PG8_STAGE(PG8_SB(1, 0), b3, voffB);
      PG8_BAR; PG8_WAIT_L(0); PG8_MMA(0, 1, At, B1); PG8_BAR;
      PG8_LDA(At, 1, 1); PG8_STAGE(PG8_SA(1, 0), a3, voffA);
      PG8_BAR; PG8_WAIT_L(0); PG8_MMA(1, 0, At, B0); PG8_BAR; PG8_SCHED;
      PG8_STAGE(PG8_SB(1, 1), b3 + hstepB, voffB);
      PG8_WAIT_V(6); PG8_BAR; PG8_MMA(1, 1, At, B1); PG8_BAR;
    }
    E(acc, cur, wr, wc, fr, fq);
    if (!has_next) break;
#pragma unroll
    for (int a = 0; a < 2; ++a)
#pragma unroll
      for (int b = 0; b < 2; ++b)
#pragma unroll
        for (int m = 0; m < 4; ++m)
#pragma unroll
          for (int n = 0; n < 2; ++n) acc[a][b][m][n] = (f32x4){0.f, 0.f, 0.f, 0.f};
    cur = nxt; cA = nA; cB = nB; ++ui;
  }
  PG8_WAIT_V(0);
  if (wr == 0) PG8_BAR;
  PG8_BAR;
#undef PG8_SA
#undef PG8_SB
#undef PG8_STAGE
#undef PG8_LDA
#undef PG8_LDB
#undef PG8_MMA
#undef PG8_WAIT_V
#undef PG8_WAIT_L
#undef PG8_BAR
#undef PG8_SCHED
}
}

struct Ctx {
  const float* const* in; float* out; unsigned char* ws; lptr lds;
  int tid, lane, wave, G, bid, zero;
};
DI float log_decay2(float p) { return log1pf(-exp2f(p)) * LOG2E; }

DI void transpose_item(const float* W, int K, int N, bf16* WT, int row_off, LAS float* scr, int item, int lane) {
  const int nblk = N / 32, kb = item / nblk, nb = item % nblk, k0 = 64 * kb, n0 = 32 * nb;
  float tv[32];
#pragma unroll
  for (int i = 0; i < 32; ++i) { const int kk = 2 * i + (lane >> 5); tv[i] = W[(size_t)(k0 + kk) * N + n0 + (lane & 31)]; }
#pragma unroll
  for (int i = 0; i < 32; ++i) { const int kk = 2 * i + (lane >> 5); scr[kk * 33 + (lane & 31)] = tv[i]; }
  LDS_WAIT(); asm volatile("" ::: "memory");
  const int c = lane & 7;
#pragma unroll
  for (int j = 0; j < 4; ++j) { const int n = (lane >> 3) + 8 * j; const LAS float* s = scr + (8 * c) * 33 + n;
    u32x4 o; o.x = pk2(s[0 * 33], s[1 * 33]); o.y = pk2(s[2 * 33], s[3 * 33]); o.z = pk2(s[4 * 33], s[5 * 33]); o.w = pk2(s[6 * 33], s[7 * 33]);
    *(u32x4*)(WT + (size_t)(row_off + n0 + n) * K + k0 + 8 * c) = o; }
  LDS_WAIT(); asm volatile("" ::: "memory");
}
DI void convert_weights(const Ctx& c, int l) {
  LAS float* scr = (LAS float*)(c.lds + c.wave * 16384);
  const int gw = c.bid * 8 + c.wave, NGW = c.G * 8;
  bf16* W1T = (bf16*)(c.ws + WS_W1T); bf16* W2T = (bf16*)(c.ws + WS_W2T); unsigned char* WA = c.ws + WS_WA;
  const int hl = l >> 1;
  const float* w1 = c.in[13] + (size_t)l * D * FF; const float* w2 = c.in[14] + (size_t)l * FF * D;
  constexpr int I1 = 16 * 128, I2 = 64 * 32;
  if ((l & 1) == 0) {
    const float* win = c.in[15] + (size_t)hl * D * ACIN; const float* wout = c.in[16] + (size_t)hl * D * D;
    constexpr int IA = 16 * 112, IB = 16 * 32;
    for (int it = gw; it < I1 + I2 + IA + IB; it += NGW) {
      int r = it;
      if (r < I1) { transpose_item(w1, D, FF, W1T, 0, scr, r, c.lane); continue; } r -= I1;
      if (r < I2) { transpose_item(w2, FF, D, W2T, 0, scr, r, c.lane); continue; } r -= I2;
      if (r < IA) { transpose_item(win, D, ACIN, (bf16*)WA, 0, scr, r, c.lane); continue; } r -= IA;
      transpose_item(wout, D, D, (bf16*)(WA + WA_OUT_E), 0, scr, r, c.lane);
    }
  } else {
    const float* winc = c.in[20] + (size_t)hl * D * 672; const float* wuq = c.in[23] + (size_t)hl * 384 * 1536;
    const float* wuk = c.in[24] + (size_t)hl * 256 * 1024; const float* wuv = c.in[25] + (size_t)hl * 256 * 1024; const float* woc = c.in[26] + (size_t)hl * D * D;
    constexpr int IA = 16 * 21, IB = 6 * 48, IC = 4 * 32, ID = 16 * 32;
    for (int it = gw; it < I1 + I2 + IA + IB + 2 * IC + ID; it += NGW) {
      int r = it;
      if (r < I1) { transpose_item(w1, D, FF, W1T, 0, scr, r, c.lane); continue; } r -= I1;
      if (r < I2) { transpose_item(w2, FF, D, W2T, 0, scr, r, c.lane); continue; } r -= I2;
      if (r < IA) { transpose_item(winc, D, 672, (bf16*)WA, 0, scr, r, c.lane); continue; } r -= IA;
      if (r < IB) { transpose_item(wuq, 384, 1536, (bf16*)(WA + WA_UQ), 0, scr, r, c.lane); continue; } r -= IB;
      if (r < IC) { transpose_item(wuk, 256, 1024, (bf16*)(WA + WA_UKV), 0, scr, r, c.lane); continue; } r -= IC;
      if (r < IC) { transpose_item(wuv, 256, 1024, (bf16*)(WA + WA_UKV), 1024, scr, r, c.lane); continue; } r -= IC;
      transpose_item(woc, D, D, (bf16*)(WA + WA_OUT_O), 0, scr, r, c.lane);
    }
    u32x4* z = (u32x4*)(WA + (size_t)672 * D * 2);
    for (int i = c.bid * 512 + c.tid; i < 96 * D * 2 / 16; i += c.G * 512) z[i] = (u32x4){(unsigned)c.zero, (unsigned)c.zero, (unsigned)c.zero, (unsigned)c.zero};
  }
}

DI void prologue(const Ctx& c) {
  float* MOD = (float*)(c.ws + WS_MOD);
  for (int item = c.bid; item < 4 * 48; item += c.G) {
    const int l = item / 48, n0 = (item % 48) * 128;
    LAS float* sil = (LAS float*)c.lds; LAS float* red = (LAS float*)(c.lds + 36864);
    for (int i = c.tid; i < 9 * 1024; i += 512) { const int r = i >> 10, k = i & 1023; const float x = (r == 0) ? c.in[9][k] : c.in[8][(r - 1) * 1024 + k]; sil[i] = x / (1.f + __expf(-x)); }
    __syncthreads();
    float acc[9][2];
#pragma unroll
    for (int r = 0; r < 9; ++r) { acc[r][0] = 0.f; acc[r][1] = 0.f; }
    const float* wp = c.in[10] + ((size_t)l * 1024 + c.wave * 128) * 6144 + n0 + 2 * c.lane;
#pragma unroll 8
    for (int k = 0; k < 128; ++k) { const f32x2 w = *(const f32x2*)(wp + (size_t)k * 6144);
#pragma unroll
      for (int r = 0; r < 9; ++r) { const float s = sil[r * 1024 + c.wave * 128 + k]; acc[r][0] += s * w.x; acc[r][1] += s * w.y; } }
#pragma unroll
    for (int r = 0; r < 9; ++r) { red[(c.wave * 9 + r) * 128 + 2 * c.lane] = acc[r][0]; red[(c.wave * 9 + r) * 128 + 2 * c.lane + 1] = acc[r][1]; }
    __syncthreads();
    for (int o = c.tid; o < 9 * 128; o += 512) { const int r = o >> 7, n = o & 127; float s = c.in[11][l * 6144 + n0 + n];
#pragma unroll
      for (int w = 0; w < 8; ++w) s += red[(w * 9 + r) * 128 + n];
      MOD[(size_t)(l * 9 + r) * 6144 + n0 + n] = s; }
    __syncthreads();
  }
  { float* RC = (float*)(c.ws + WS_ROPE); float* RS = RC + 32768;
    for (int i = c.bid * 512 + c.tid; i < 2048 * 16; i += c.G * 512) { const int t = i >> 4, j = i & 15; const float pos = (float)((j < 8) ? (t >> 6) : (t & 63));
      const float inv = exp2f(-(float)(j & 7) * 0.125f * 13.287712379549449f); const float a = pos * inv;
      const float k = rintf(a * 0.15915494309189535f); float r = fmaf(-k, 6.2831854820251465f, a); r = fmaf(k, 1.7484556e-07f, r);
      RC[i] = __cosf(r); RS[i] = __sinf(r); } }
  { bf16* NC = (bf16*)(c.ws + WS_NACTX);
    for (int i = c.bid * 512 + c.tid; i < 2 * 2 * 8 * 8 * 256 * 16; i += c.G * 512) {
      const int e4 = i & 15, key = (i >> 4) & 255, h = (i >> 12) & 7, b = (i >> 15) & 7, kv = (i >> 18) & 1, ia = (i >> 19) & 1;
      const f32x4 v = *(const f32x4*)(c.in[4 + kv] + ((((size_t)b * 2 + ia) * 8 + h) * 256 + key) * 64 + 4 * e4);
      u32x2 o; o.x = pk2(v[0], v[1]); o.y = pk2(v[2], v[3]); *(u32x2*)(NC + (size_t)i * 4) = o; } }
  convert_weights(c, 0);
}

DI void row_phase(const Ctx& c, int l, int kind) {
  const float* MOD = (const float*)(c.ws + WS_MOD); const float* NG = c.in[12];
  const bf16* Y = (const bf16*)(c.ws + WS_Y); bf16* Hb = (bf16*)(c.ws + WS_H);
  const int gw = c.bid * 8 + c.wave, NGW = c.G * 8;
  const int hl = (kind == 2) ? l + 1 : l;
  const bool want_h = hl < 4;
  const float* gy = NG + (size_t)(l * 4 + (kind == 1 ? 1 : 3)) * D;
  const float* gh = NG + (size_t)((want_h ? hl : 0) * 4 + (kind == 1 ? 2 : 0)) * D;
  constexpr int RB = 2;
#define ROFF(q) (8 * (c.lane + 64 * ((q) >> 1)) + 4 * ((q) & 1))
#define ROW_LOAD(X, YA, YB, M0) do { \
    _Pragma("unroll") for (int k = 0; k < RB; ++k) { const int m = (M0) + k * NGW; if (m < NT) { \
      const float* xs = (kind == 0 || (kind == 1 && l == 0)) ? ((m < NP) ? c.in[0] + (size_t)m * D : c.in[1] + (size_t)(m - NP) * D) : c.out + (size_t)m * D; \
      _Pragma("unroll") for (int j = 0; j < 2; ++j) { const int o = 8 * (c.lane + 64 * j); \
        if (kind == 1) YA[k][j] = *(const u32x4*)(Y + (size_t)m * D + o); \
        if (kind == 2) { YA[k][j] = *(const u32x4*)(Y + (size_t)m * 2 * D + o); YB[k][j] = *(const u32x4*)(Y + (size_t)m * 2 * D + D + o); } \
        X[k][2 * j] = *(const f32x4*)(xs + o); X[k][2 * j + 1] = *(const f32x4*)(xs + o + 4); } } } } while (0)
#define ROW_PROC(X, YA, YB, M0) do { \
    _Pragma("unroll") for (int k = 0; k < RB; ++k) { const int m = (M0) + k * NGW; if (m < NT) { \
      const int r = (m < NP) ? 0 : 1 + ((m - NP) >> 11); \
      float* xo = c.out + (size_t)m * D; \
      if (kind != 0) { \
        const float* gate = MOD + ((size_t)(l * 9 + r) * 6 + (kind == 1 ? 2 : 5)) * D; \
        f32x4 y[4]; \
        _Pragma("unroll") for (int j = 0; j < 2; ++j) { const u32x4 w = YA[k][j]; \
          y[2 * j] = (f32x4){bflo(w.x), bfhi(w.x), bflo(w.y), bfhi(w.y)}; y[2 * j + 1] = (f32x4){bflo(w.z), bfhi(w.z), bflo(w.w), bfhi(w.w)}; \
          if (kind == 2) { const u32x4 w2 = YB[k][j]; \
            y[2 * j] += (f32x4){bflo(w2.x), bfhi(w2.x), bflo(w2.y), bfhi(w2.y)}; y[2 * j + 1] += (f32x4){bflo(w2.z), bfhi(w2.z), bflo(w2.w), bfhi(w2.w)}; } } \
        float ss = 0.f; \
        _Pragma("unroll") for (int q = 0; q < 4; ++q) ss += y[q][0] * y[q][0] + y[q][1] * y[q][1] + y[q][2] * y[q][2] + y[q][3] * y[q][3]; \
        const float rs = 1.0f / sqrtf(wave_sum(ss) * (1.f / D) + EPS); \
        _Pragma("unroll") for (int q = 0; q < 4; ++q) { const f32x4 g = gyr[q]; const f32x4 gt = *(const f32x4*)(gate + ROFF(q)); \
          X[k][q] = X[k][q] + gt * (y[q] * rs * g); } \
        _Pragma("unroll") for (int q = 0; q < 4; ++q) *(f32x4*)(xo + ROFF(q)) = X[k][q]; \
      } \
      if (want_h) { \
        const float* shift = MOD + ((size_t)(hl * 9 + r) * 6 + (kind == 1 ? 3 : 0)) * D; const float* scale = shift + D; \
        float ss = 0.f; \
        _Pragma("unroll") for (int q = 0; q < 4; ++q) ss += X[k][q][0] * X[k][q][0] + X[k][q][1] * X[k][q][1] + X[k][q][2] * X[k][q][2] + X[k][q][3] * X[k][q][3]; \
        const float rs = 1.0f / sqrtf(wave_sum(ss) * (1.f / D) + EPS); \
        _Pragma("unroll") for (int j = 0; j < 2; ++j) { u32x4 w; \
          _Pragma("unroll") for (int hf = 0; hf < 2; ++hf) { const int q = 2 * j + hf, o = ROFF(q); const f32x4 g = ghr[q]; const f32x4 sh = *(const f32x4*)(shift + o); const f32x4 sc = *(const f32x4*)(scale + o); \
            const f32x4 hv = (X[k][q] * rs * g) * (sc + 1.0f) + sh; \
            if (hf == 0) { w.x = pk2(hv[0], hv[1]); w.y = pk2(hv[2], hv[3]); } else { w.z = pk2(hv[0], hv[1]); w.w = pk2(hv[2], hv[3]); } } \
          *(u32x4*)(Hb + (size_t)m * D + 8 * (c.lane + 64 * j)) = w; } \
      } } } } while (0)
  f32x4 gyr[4], ghr[4];
#pragma unroll
  for (int q = 0; q < 4; ++q) { gyr[q] = *(const f32x4*)(gy + ROFF(q)); ghr[q] = *(const f32x4*)(gh + ROFF(q)); }
  f32x4 xA[RB][4], xB[RB][4]; u32x4 yaA[RB][2], ybA[RB][2], yaB[RB][2], ybB[RB][2];
  const int step = RB * NGW;
  int m0 = gw;
  ROW_LOAD(xA, yaA, ybA, m0);
  for (; m0 < NT; m0 += 2 * step) {
    ROW_LOAD(xB, yaB, ybB, m0 + step);
    ROW_PROC(xA, yaA, ybA, m0);
    ROW_LOAD(xA, yaA, ybA, m0 + 2 * step);
    ROW_PROC(xB, yaB, ybB, m0 + step);
  }
#undef ROW_LOAD
#undef ROW_PROC
#undef ROFF
}

DI void mla_rows(const Ctx& c, int ic) {
  const float* Cb = (const float*)(c.ws + WS_BIG); bf16* CQ = (bf16*)(c.ws + WS_H); bf16* CKV = (bf16*)(c.ws + WS_H + H_CKVN); bf16* KPE = (bf16*)(c.ws + WS_KPE);
  const float* RC = (const float*)(c.ws + WS_ROPE); const float* RS = RC + 32768;
  const float* qn = c.in[21] + ic * 384; const float* kvn = c.in[22] + ic * 256;
  const int gw = c.bid * 8 + c.wave, NGW = c.G * 8;
  constexpr int RB = 3;
  const bool ql = c.lane < 48;
  for (int m0 = gw; m0 < NT; m0 += RB * NGW) {
    f32x4 qa[RB], qb[RB], kv[RB]; float xk[RB];
#pragma unroll
    for (int k = 0; k < RB; ++k) { const int m = m0 + k * NGW; if (m < NT) { const float* cr = Cb + (size_t)m * CINP;
      qa[k] = ql ? *(const f32x4*)(cr + 8 * c.lane) : (f32x4){0.f, 0.f, 0.f, 0.f}; qb[k] = ql ? *(const f32x4*)(cr + 8 * c.lane + 4) : (f32x4){0.f, 0.f, 0.f, 0.f};
      kv[k] = *(const f32x4*)(cr + 384 + 4 * c.lane); xk[k] = cr[640 + (c.lane & 31)]; } }
#pragma unroll
    for (int k = 0; k < RB; ++k) { const int m = m0 + k * NGW; if (m < NT) {
      float ss = qa[k][0] * qa[k][0] + qa[k][1] * qa[k][1] + qa[k][2] * qa[k][2] + qa[k][3] * qa[k][3] + qb[k][0] * qb[k][0] + qb[k][1] * qb[k][1] + qb[k][2] * qb[k][2] + qb[k][3] * qb[k][3];
      float rs = 1.0f / sqrtf(wave_sum(ss) * (1.f / 384.f) + EPS);
      if (ql) { const f32x4 g0 = *(const f32x4*)(qn + 8 * c.lane), g1 = *(const f32x4*)(qn + 8 * c.lane + 4); const f32x4 a = qa[k] * rs * g0, b = qb[k] * rs * g1;
        u32x4 w; w.x = pk2(a[0], a[1]); w.y = pk2(a[2], a[3]); w.z = pk2(b[0], b[1]); w.w = pk2(b[2], b[3]); *(u32x4*)(CQ + (size_t)m * 384 + 8 * c.lane) = w; }
      ss = kv[k][0] * kv[k][0] + kv[k][1] * kv[k][1] + kv[k][2] * kv[k][2] + kv[k][3] * kv[k][3];
      rs = 1.0f / sqrtf(wave_sum(ss) * (1.f / 256.f) + EPS);
      const f32x4 kn = kv[k] * rs * *(const f32x4*)(kvn + 4 * c.lane);
      u32x2 w; w.x = pk2(kn[0], kn[1]); w.y = pk2(kn[2], kn[3]); *(u32x2*)(CKV + (size_t)m * 256 + 4 * c.lane) = w;
      const float pk = __shfl_xor(xk[k], 1);
      if (m < NP) { const int b = m >> 8, s = m & 255; const size_t slot = ((size_t)(b * 2 + ic) * 256 + s);
        *(f32x4*)(c.out + O_CKV + slot * 256 + 4 * c.lane) = kn;
        if (c.lane < 32) { c.out[O_KPE + slot * 32 + c.lane] = xk[k]; KPE[(size_t)m * 32 + c.lane] = f2bf(xk[k]); }
      } else { const int pos = (m - NP) & 2047; const int pi = (c.lane & 31) >> 1; const float cs = RC[pos * 16 + pi], sn = RS[pos * 16 + pi];
        const float val = (c.lane & 1) ? (pk * sn + xk[k] * cs) : (xk[k] * cs - pk * sn);
        if (c.lane < 32) KPE[(size_t)m * 32 + c.lane] = f2bf(val); }
    } }
  }
  for (int m = NT + gw; m < NT + NCTX; m += NGW) {
    const int cr = m - NT, b = cr >> 8, s = cr & 255; const size_t slot = ((size_t)(b * 2 + ic) * 256 + s);
    const f32x4 kv = *(const f32x4*)(c.in[6] + slot * 256 + 4 * c.lane);
    u32x2 w; w.x = pk2(kv[0], kv[1]); w.y = pk2(kv[2], kv[3]); *(u32x2*)(CKV + (size_t)m * 256 + 4 * c.lane) = w;
    if (c.lane < 32) KPE[(size_t)m * 32 + c.lane] = f2bf(c.in[7][slot * 32 + c.lane]);
  }
}

DI void ret_kv_item(const Ctx& c, int item, int ia) {
  const int p = item >> 3, h = item & 7;
  const bf16* Pb = (const bf16*)(c.ws + WS_BIG);
  float* KVF = (float*)(c.ws + WS_Y); float* KVB = (float*)(c.ws + WS_Y + Y_KVB);
  const float lgf2 = log_decay2(c.in[17][ia * 8 + h]), lgb2 = log_decay2(c.in[18][ia * 8 + h]);
  LAS bf16* Kn = (LAS bf16*)c.lds; LAS bf16* VF = (LAS bf16*)(c.lds + 36864); LAS bf16* VB = (LAS bf16*)(c.lds + 73728);
#pragma unroll
  for (int it = 0; it < 4; ++it) { const int q = c.tid + 512 * it, tok = q >> 3, part = q & 7;
    const bf16* rowp = Pb + (size_t)(256 * p + tok) * ACIN + h * 64 + part * 8;
    const u32x4 kk = *(const u32x4*)(rowp + 512); const u32x4 vv = *(const u32x4*)(rowp + 1024);
    const int i = tok & 127; const float df = exp2f(lgf2 * (float)(127 - i)), db = exp2f(lgb2 * (float)i);
    u32x4 vf, vb;
#pragma unroll
    for (int j = 0; j < 4; ++j) { const float v0 = bflo(vv[j]), v1 = bfhi(vv[j]); vf[j] = pk2(v0 * df, v1 * df); vb[j] = pk2(v0 * db, v1 * db); }
    *(LAS u32x4*)(Kn + tok * 72 + part * 8) = kk; *(LAS u32x4*)(VF + tok * 72 + part * 8) = vf; *(LAS u32x4*)(VB + tok * 72 + part * 8) = vb; }
  __syncthreads();
  { const int cw = c.wave >> 2, dir = (c.wave >> 1) & 1, eb = c.wave & 1, r = c.lane & 31, hh = c.lane >> 5;
    const int tq = (c.lane & 15) >> 2, tp = c.lane & 3, tblk = (c.lane >> 4) & 1;
    const LAS bf16* Vd = dir ? VB : VF;
    f32x16 a0 = zero16(), a1 = zero16();
#pragma unroll
    for (int ks = 0; ks < 8; ++ks) { const int row = cw * 128 + 16 * ks + 8 * hh + tq, col = 16 * tblk + 4 * tp;
      const bf16x8 A = cat8(tr_read(Vd + row * 72 + eb * 32 + col), tr_read(Vd + (row + 4) * 72 + eb * 32 + col));
      const bf16x8 B0 = cat8(tr_read(Kn + row * 72 + col), tr_read(Kn + (row + 4) * 72 + col));
      const bf16x8 B1 = cat8(tr_read(Kn + row * 72 + 32 + col), tr_read(Kn + (row + 4) * 72 + 32 + col));
      a0 = MFMA32(A, B0, a0); a1 = MFMA32(A, B1, a1); }
    float* dst = (dir ? KVB : KVF) + ((size_t)((2 * p + cw) * 8 + h) * 64) * 64;
#pragma unroll
    for (int reg = 0; reg < 16; ++reg) { const int e = eb * 32 + crow(reg, hh); dst[e * 64 + r] = a0[reg]; dst[e * 64 + 32 + r] = a1[reg]; } }
  __syncthreads();
}

DI void ret_out_item(const Ctx& c, int item, int ia) {
  const int p = item >> 3, h = item & 7;
  const bf16* Pb = (const bf16*)(c.ws + WS_BIG); bf16* AO = (bf16*)(c.ws + WS_H);
  const float* KVF = (const float*)(c.ws + WS_Y); const float* KVB = (const float*)(c.ws + WS_Y + Y_KVB);
  const float lgf2 = log_decay2(c.in[17][ia * 8 + h]), lgb2 = log_decay2(c.in[18][ia * 8 + h]);
  LAS bf16* Ks = (LAS bf16*)c.lds; LAS bf16* Vs = (LAS bf16*)(c.lds + 36864); LAS bf16* St = (LAS bf16*)(c.lds + 73728);
#pragma unroll
  for (int it = 0; it < 4; ++it) { const int q = c.tid + 512 * it, tok = q >> 3, part = q & 7;
    const bf16* rowp = Pb + (size_t)(256 * p + tok) * ACIN + h * 64 + part * 8;
    const u32x4 kk = *(const u32x4*)(rowp + 512); const u32x4 vv = *(const u32x4*)(rowp + 1024);
    *(LAS u32x4*)(Ks + tok * 72 + part * 8) = kk; *(LAS u32x4*)(Vs + tok * 72 + part * 8) = vv; }
  { const bool lat = p >= 32; const int b = lat ? ((p - 32) >> 3) : p; const int n0 = lat ? 2 * ((p - 32) & 7) : 0; const int N = lat ? 16 : 2; const int cbase = lat ? 64 + b * 16 : 2 * p;
    const int e = c.tid >> 3, d0 = (c.tid & 7) * 8;
    const float Gf = exp2f(lgf2 * 128.f), Gb = exp2f(lgb2 * 128.f);
    const size_t eo = (size_t)e * 64 + d0;
    float sf[8], sb[8];
    if (lat) { const float* s0f = c.in[2] + ((size_t)((b * 2 + ia) * 8 + h) * 64) * 64; const float* s0b = c.in[3] + ((size_t)((b * 2 + ia) * 8 + h) * 64) * 64;
#pragma unroll
      for (int j = 0; j < 8; ++j) { sf[j] = s0f[(d0 + j) * 64 + e]; sb[j] = s0b[(d0 + j) * 64 + e]; }
    } else {
#pragma unroll
      for (int j = 0; j < 8; ++j) { sf[j] = 0.f; sb[j] = 0.f; } }
    for (int j0 = 0; j0 < n0; j0 += 4) {
      f32x4 a[4], bq[4];
#pragma unroll
      for (int u = 0; u < 4; ++u) { const int j = min(j0 + u, n0 - 1); const float* kv = KVF + ((size_t)((cbase + j) * 8 + h) * 4096) + eo; a[u] = *(const f32x4*)kv; bq[u] = *(const f32x4*)(kv + 4); }
#pragma unroll
      for (int u = 0; u < 4; ++u) if (j0 + u < n0) {
#pragma unroll
        for (int q = 0; q < 4; ++q) { sf[q] = Gf * sf[q] + a[u][q]; sf[4 + q] = Gf * sf[4 + q] + bq[u][q]; } } }
    for (int j0 = N - 1; j0 >= n0 + 2; j0 -= 4) {
      f32x4 a[4], bq[4];
#pragma unroll
      for (int u = 0; u < 4; ++u) { const int j = max(j0 - u, n0 + 2); const float* kv = KVB + ((size_t)((cbase + j) * 8 + h) * 4096) + eo; a[u] = *(const f32x4*)kv; bq[u] = *(const f32x4*)(kv + 4); }
#pragma unroll
      for (int u = 0; u < 4; ++u) if (j0 - u >= n0 + 2) {
#pragma unroll
        for (int q = 0; q < 4; ++q) { sb[q] = Gb * sb[q] + a[u][q]; sb[4 + q] = Gb * sb[4 + q] + bq[u][q]; } } }
    { u32x4 w; w.x = pk2(sf[0], sf[1]); w.y = pk2(sf[2], sf[3]); w.z = pk2(sf[4], sf[5]); w.w = pk2(sf[6], sf[7]); *(LAS u32x4*)(St + 0 * 4608 + e * 72 + d0) = w; }
    { u32x4 w; w.x = pk2(sb[0], sb[1]); w.y = pk2(sb[2], sb[3]); w.z = pk2(sb[4], sb[5]); w.w = pk2(sb[6], sb[7]); *(LAS u32x4*)(St + 3 * 4608 + e * 72 + d0) = w; }
    { const float* kv = KVF + ((size_t)((cbase + n0) * 8 + h) * 4096) + eo; const f32x4 a = *(const f32x4*)kv, bq = *(const f32x4*)(kv + 4);
#pragma unroll
      for (int q = 0; q < 4; ++q) { sf[q] = Gf * sf[q] + a[q]; sf[4 + q] = Gf * sf[4 + q] + bq[q]; } }
    { const float* kv = KVB + ((size_t)((cbase + n0 + 1) * 8 + h) * 4096) + eo; const f32x4 a = *(const f32x4*)kv, bq = *(const f32x4*)(kv + 4);
#pragma unroll
      for (int q = 0; q < 4; ++q) { sb[q] = Gb * sb[q] + a[q]; sb[4 + q] = Gb * sb[4 + q] + bq[q]; } }
    { u32x4 w; w.x = pk2(sf[0], sf[1]); w.y = pk2(sf[2], sf[3]); w.z = pk2(sf[4], sf[5]); w.w = pk2(sf[6], sf[7]); *(LAS u32x4*)(St + 1 * 4608 + e * 72 + d0) = w; }
    { u32x4 w; w.x = pk2(sb[0], sb[1]); w.y = pk2(sb[2], sb[3]); w.z = pk2(sb[4], sb[5]); w.w = pk2(sb[6], sb[7]); *(LAS u32x4*)(St + 2 * 4608 + e * 72 + d0) = w; }
    if (!lat) {
      const float* kv1 = KVF + ((size_t)((cbase + 1) * 8 + h) * 4096) + eo; const float* kv0 = KVB + ((size_t)((cbase + 0) * 8 + h) * 4096) + eo;
      float* of = c.out + O_RF + ((size_t)((b * 2 + ia) * 8 + h) * 64) * 64; float* ob = c.out + O_RB + ((size_t)((b * 2 + ia) * 8 + h) * 64) * 64;
#pragma unroll
      for (int j = 0; j < 8; ++j) { of[(d0 + j) * 64 + e] = Gf * sf[j] + kv1[j]; ob[(d0 + j) * 64 + e] = Gb * sb[j] + kv0[j]; } }
  }
  __syncthreads();
  { const int cw = c.wave >> 2, r = c.lane & 31, hh = c.lane >> 5; const int iloc = 32 * (c.wave & 3) + r; const int m = 256 * p + 128 * cw + iloc;
    bf16x8 Qf[4];
#pragma unroll
    for (int ks = 0; ks < 4; ++ks) Qf[ks] = *(const bf16x8*)(Pb + (size_t)m * ACIN + h * 64 + 16 * ks + 8 * hh);
    f32x16 O0, O1;
    { const float decf = exp2f(lgf2 * (float)(iloc + 1)), decb = exp2f(lgb2 * (float)(128 - iloc));
      f32x16 f0 = zero16(), f1 = zero16();
      LAS bf16* SF = St + cw * 4608; LAS bf16* SB = St + (2 + cw) * 4608;
#pragma unroll
      for (int ks = 0; ks < 4; ++ks) { const int ko = 16 * ks + 8 * hh;
        f0 = MFMA32(*(const LAS bf16x8*)(SF + r * 72 + ko), Qf[ks], f0); f1 = MFMA32(*(const LAS bf16x8*)(SF + (32 + r) * 72 + ko), Qf[ks], f1); }
#pragma unroll
      for (int reg = 0; reg < 16; ++reg) { O0[reg] = decf * f0[reg]; O1[reg] = decf * f1[reg]; }
      f0 = zero16(); f1 = zero16();
#pragma unroll
      for (int ks = 0; ks < 4; ++ks) { const int ko = 16 * ks + 8 * hh;
        f0 = MFMA32(*(const LAS bf16x8*)(SB + r * 72 + ko), Qf[ks], f0); f1 = MFMA32(*(const LAS bf16x8*)(SB + (32 + r) * 72 + ko), Qf[ks], f1); }
#pragma unroll
      for (int reg = 0; reg < 16; ++reg) { O0[reg] += decb * f0[reg]; O1[reg] += decb * f1[reg]; } }
#pragma unroll 1
    for (int kb = 0; kb < 4; ++kb) {
      f32x16 s = zero16();
#pragma unroll
      for (int ks = 0; ks < 4; ++ks) { const bf16x8 A = *(const LAS bf16x8*)(Ks + (128 * cw + 32 * kb + r) * 72 + 16 * ks + 8 * hh); s = MFMA32(A, Qf[ks], s); }
#pragma unroll
      for (int reg = 0; reg < 16; ++reg) { const int diff = iloc - (32 * kb + crow(reg, hh));
        const float ex = __builtin_amdgcn_exp2f((diff > 0 ? lgf2 : -lgb2) * (float)diff);
        s[reg] *= (diff == 0) ? 2.0f : ex; }
#pragma unroll
      for (int sp = 0; sp < 2; ++sp) {
        u32x4 pw; pw.x = pk2(s[8 * sp + 0], s[8 * sp + 1]); pw.y = pk2(s[8 * sp + 2], s[8 * sp + 3]); pw.z = pk2(s[8 * sp + 4], s[8 * sp + 5]); pw.w = pk2(s[8 * sp + 6], s[8 * sp + 7]);
        const bf16x8 Pf = __builtin_bit_cast(bf16x8, pw);
        const int vrow = 128 * cw + 32 * kb + 16 * sp + 4 * hh + ((c.lane & 15) >> 2), vcol = 16 * ((c.lane >> 4) & 1) + 4 * (c.lane & 3);
        O0 = MFMA32(cat8(tr_read(Vs + vrow * 72 + vcol), tr_read(Vs + (vrow + 8) * 72 + vcol)), Pf, O0);
        O1 = MFMA32(cat8(tr_read(Vs + vrow * 72 + 32 + vcol), tr_read(Vs + (vrow + 8) * 72 + 32 + vcol)), Pf, O1);
      }
    }
    float sm = 0.f;
#pragma unroll
    for (int reg = 0; reg < 16; ++reg) sm += O0[reg] + O1[reg];
    sm += __shfl_xor(sm, 32); const float mu = sm * (1.f / 64.f);
    float vs = 0.f;
#pragma unroll
    for (int reg = 0; reg < 16; ++reg) { const float a = O0[reg] - mu, bq = O1[reg] - mu; vs += a * a + bq * bq; }
    vs += __shfl_xor(vs, 32); const float rs = 1.0f / sqrtf(vs * (1.f / 64.f) + EPS);
    const bf16* gp = Pb + (size_t)m * ACIN + 1536 + h * 64; bf16* op = AO + (size_t)m * D + h * 64;
#pragma unroll
    for (int eb = 0; eb < 2; ++eb)
#pragma unroll
      for (int g = 0; g < 4; ++g) { const int e = eb * 32 + 8 * g + 4 * hh; const u32x2 gw = *(const u32x2*)(gp + e);
        float gv[4] = {bflo(gw.x), bfhi(gw.x), bflo(gw.y), bfhi(gw.y)}; float ov[4];
#pragma unroll
        for (int j = 0; j < 4; ++j) { const float o = ((eb ? O1[4 * g + j] : O0[4 * g + j]) - mu) * rs; const float gg = gv[j]; ov[j] = o * (gg * __builtin_amdgcn_rcpf(1.f + __expf(-gg))); }
        u32x2 w; w.x = pk2(ov[0], ov[1]); w.y = pk2(ov[2], ov[3]); *(u32x2*)(op + e) = w; }
  }
  __syncthreads();
}

template <int MODE> DI void attn_item(const Ctx& c, int item, int hl) {
  constexpr int DQK = (MODE >= 2) ? 96 : 64, KS = DQK / 16, KLD = DQK + 8, VLD = 72, BUFB = 24576, VOFF = 13312;
  const int r = c.lane & 31, hh = c.lane >> 5, w = c.wave;
  const bf16* Pb = (const bf16*)(c.ws + WS_BIG);
  const bf16* KVb = (const bf16*)(c.ws + WS_BIG + BIG_KV);
  const bf16* KPE = (const bf16*)(c.ws + WS_KPE);
  const bf16* NC = (const bf16*)(c.ws + WS_NACTX);
  bf16* AO = (bf16*)(c.ws + WS_H);
  int b, h, g = 0, m, nt, nloc = 0, Rlo = 0, qr = 0, qc = 0, wsr = 0, wsc = 0;
  if (MODE == 0) { b = item >> 3; h = item & 7; m = b * 256 + 32 * w + r; nt = 4; }
  else if (MODE == 1) { b = item >> 6; h = (item >> 3) & 7; g = item & 7; qr = 4 * g + (w >> 1); qc = 32 * (w & 1) + r; m = NP + b * 2048 + qr * 64 + qc;
    Rlo = max(4 * g - 4, 0); Rlo = min(Rlo, 24); const int Rhi = min(max(4 * g - 1, 0), 24) + 7; nloc = Rhi - Rlo + 1; nt = nloc + 4;
    wsr = min(max(qr - 4, 0), 24); wsc = min(max(qc - 8, 0), 48); }
  else if (MODE == 2) { b = item >> 4; h = item & 15; m = b * 256 + 32 * w + r; nt = 4; }
  else { b = item >> 7; h = (item >> 3) & 15; g = item & 7; m = NP + b * 2048 + g * 256 + 32 * w + r; nt = 36; }
  const float sc2 = ((MODE >= 2) ? 0.10206207261596577f : 0.125f) * LOG2E;
  LAS float* rpbs = (LAS float*)(c.lds + 49152);
  if (MODE == 1) { for (int i = c.tid; i < 465; i += 512) rpbs[i] = c.in[19][(size_t)(hl * 8 + h) * 465 + i] * LOG2E; }
  bf16x8 Qf[KS]; bf16x8 Qr[2];
  if (MODE < 2) {
#pragma unroll
    for (int ks = 0; ks < KS; ++ks) Qf[ks] = *(const bf16x8*)(Pb + (size_t)m * ACIN + 2048 + h * 64 + 16 * ks + 8 * hh);
  } else {
#pragma unroll
    for (int ks = 0; ks < KS; ++ks) Qf[ks] = *(const bf16x8*)(Pb + (size_t)m * 1536 + h * 96 + 16 * ks + 8 * hh);
  }
  if (MODE == 3) { const float* RC = (const float*)(c.ws + WS_ROPE); const float* RS = RC + 32768; const int pos = g * 256 + 32 * w + r;
#pragma unroll
    for (int k2 = 0; k2 < 2; ++k2) { const f32x4 cs = *(const f32x4*)(RC + pos * 16 + 8 * k2 + 4 * hh), sn = *(const f32x4*)(RS + pos * 16 + 8 * k2 + 4 * hh);
      const u32x4 xw = __builtin_bit_cast(u32x4, Qf[4 + k2]); u32x4 ow;
#pragma unroll
      for (int q = 0; q < 4; ++q) { const float x1 = bflo(xw[q]), x2 = bfhi(xw[q]); ow[q] = pk2(x1 * cs[q] - x2 * sn[q], x1 * sn[q] + x2 * cs[q]); }
      Qr[k2] = __builtin_bit_cast(bf16x8, ow); } }
  const int skey = c.tid >> 3, spart = c.tid & 7, pkey = c.tid >> 2, ppart = c.tid & 3;
  u32x4 kreg = {0u,0u,0u,0u}, vreg = {0u,0u,0u,0u}, preg = {0u,0u,0u,0u};
#define TILE_ROW(t) ((MODE == 0 || MODE == 2) ? (b * 256 + 64 * (t)) : (MODE == 1) ? (NP + b * 2048 + (Rlo + (t)) * 64) : (((t) < 32) ? NP + b * 2048 + 64 * (t) : NT + b * 256 + 64 * ((t) - 32)))
#define LOAD_TILE(t) do { \
    if (MODE == 0 || (MODE == 1 && (t) < nloc)) { const bf16* rp_ = Pb + (size_t)(TILE_ROW(t) + skey) * ACIN + h * 64 + spart * 8; kreg = *(const u32x4*)(rp_ + 2560); vreg = *(const u32x4*)(rp_ + 3072); } \
    else if (MODE == 1) { const int tc_ = (t) - nloc; const size_t base_ = ((size_t)((hl * 2 + 0) * 8 + b) * 8 + h) * 16384 + (size_t)(64 * tc_ + skey) * 64 + spart * 8; \
      kreg = *(const u32x4*)(NC + base_); vreg = *(const u32x4*)(NC + base_ + (size_t)8 * 8 * 16384); } \
    else { const int row_ = TILE_ROW(t); const bf16* rp_ = KVb + (size_t)(row_ + skey) * 2048 + h * 64 + spart * 8; kreg = *(const u32x4*)rp_; vreg = *(const u32x4*)(rp_ + 1024); \
      if (c.tid < 256) preg = *(const u32x4*)(KPE + (size_t)(row_ + pkey) * 32 + ppart * 8); } } while (0)
#define STORE_TILE(bufi) do { \
    LAS bf16* Ks_ = (LAS bf16*)(c.lds + (bufi) * BUFB); LAS bf16* Vt_ = (LAS bf16*)(c.lds + (bufi) * BUFB + VOFF); \
    *(LAS u32x4*)(Ks_ + skey * KLD + spart * 8) = kreg; \
    if (MODE >= 2) { if (c.tid < 256) *(LAS u32x4*)(Ks_ + pkey * KLD + 64 + ppart * 8) = preg; } \
    *(LAS u32x4*)(Vt_ + skey * VLD + spart * 8) = vreg; } while (0)
  f32x16 O0 = zero16(), O1 = zero16();
  float mrun = -1e30f, lrun = 0.f;
  LOAD_TILE(0); STORE_TILE(0);
  __syncthreads();
  if (w >= 4) __builtin_amdgcn_s_setprio(1);
  for (int t = 0; t < nt; ++t) {
    if (t + 1 < nt) LOAD_TILE(t + 1);
    bool active = true; int R = 0;
    if (MODE == 1 && t < nloc) { R = Rlo + t; active = (R >= wsr) && (R < wsr + 8); }
    if (active) {
      LAS bf16* Ks = (LAS bf16*)(c.lds + (t & 1) * BUFB); LAS bf16* Vt = (LAS bf16*)(c.lds + (t & 1) * BUFB + VOFF);
      f32x16 s0 = zero16(), s1 = zero16();
      const bool rot = (MODE == 3) && (t < 32);
#pragma unroll
      for (int ks = 0; ks < KS; ++ks) { bf16x8 q = Qf[ks]; if (MODE == 3 && ks >= 4) q = rot ? Qr[ks - 4] : Qf[ks];
        const bf16x8 A0 = *(const LAS bf16x8*)(Ks + r * KLD + 16 * ks + 8 * hh); const bf16x8 A1 = *(const LAS bf16x8*)(Ks + (32 + r) * KLD + 16 * ks + 8 * hh);
        s0 = MFMA32(A0, q, s0); s1 = MFMA32(A1, q, s1); }
      float tmax = -1e30f, mnew, alpha;
      if (MODE == 1 && t < nloc) {
        const int dro = (R - qr + 7) * 31;
#pragma unroll
        for (int reg = 0; reg < 16; ++reg) { const int k0 = crow(reg, hh) - wsc, k1 = k0 + 32;
          const bool v0 = (unsigned)k0 < 16u, v1 = (unsigned)k1 < 16u;
          const int bo = dro + wsc - qc + 15;
          const float b0 = rpbs[v0 ? bo + k0 : 0], b1 = rpbs[v1 ? bo + k1 : 0];
          s0[reg] = v0 ? fmaf(s0[reg], sc2, b0) : -1e30f; s1[reg] = v1 ? fmaf(s1[reg], sc2, b1) : -1e30f;
          tmax = fmax_nc(tmax, s0[reg]); tmax = fmax_nc(tmax, s1[reg]); }
        tmax = fmaxf(tmax, __shfl_xor(tmax, 32));
        mnew = fmaxf(mrun, tmax); alpha = __builtin_amdgcn_exp2f(mrun - mnew); mrun = mnew;
#pragma unroll
        for (int reg = 0; reg < 16; ++reg) { s0[reg] = __builtin_amdgcn_exp2f(s0[reg] - mnew); s1[reg] = __builtin_amdgcn_exp2f(s1[reg] - mnew); }
      } else {
#pragma unroll
        for (int reg = 0; reg < 16; ++reg) { tmax = fmax_nc(tmax, s0[reg]); tmax = fmax_nc(tmax, s1[reg]); }
        tmax = fmaxf(tmax, __shfl_xor(tmax, 32));
        mnew = fmaxf(mrun, tmax * sc2); alpha = __builtin_amdgcn_exp2f(mrun - mnew); mrun = mnew;
#pragma unroll
        for (int reg = 0; reg < 16; ++reg) { s0[reg] = __builtin_amdgcn_exp2f(fmaf(s0[reg], sc2, -mnew)); s1[reg] = __builtin_amdgcn_exp2f(fmaf(s1[reg], sc2, -mnew)); }
      }
      float ps = 0.f;
#pragma unroll
      for (int reg = 0; reg < 16; ++reg) ps += s0[reg] + s1[reg];
      lrun = lrun * alpha + ps;
#pragma unroll
      for (int reg = 0; reg < 16; ++reg) { O0[reg] *= alpha; O1[reg] *= alpha; }
#pragma unroll
      for (int kb = 0; kb < 2; ++kb)
#pragma unroll
        for (int sp = 0; sp < 2; ++sp) {
          u32x4 pw;
          if (kb == 0) { pw.x = pk2(s0[8 * sp + 0], s0[8 * sp + 1]); pw.y = pk2(s0[8 * sp + 2], s0[8 * sp + 3]); pw.z = pk2(s0[8 * sp + 4], s0[8 * sp + 5]); pw.w = pk2(s0[8 * sp + 6], s0[8 * sp + 7]); }
          else { pw.x = pk2(s1[8 * sp + 0], s1[8 * sp + 1]); pw.y = pk2(s1[8 * sp + 2], s1[8 * sp + 3]); pw.z = pk2(s1[8 * sp + 4], s1[8 * sp + 5]); pw.w = pk2(s1[8 * sp + 6], s1[8 * sp + 7]); }
          const bf16x8 Pf = __builtin_bit_cast(bf16x8, pw);
          const int vrow = 32 * kb + 16 * sp + 4 * hh + ((c.lane & 15) >> 2), vcol = 16 * ((c.lane >> 4) & 1) + 4 * (c.lane & 3);
          O0 = MFMA32(cat8(tr_read(Vt + vrow * VLD + vcol), tr_read(Vt + (vrow + 8) * VLD + vcol)), Pf, O0);
          O1 = MFMA32(cat8(tr_read(Vt + vrow * VLD + 32 + vcol), tr_read(Vt + (vrow + 8) * VLD + 32 + vcol)), Pf, O1);
        }
    }
    if (t + 1 < nt) STORE_TILE((t + 1) & 1);
    __syncthreads();
  }
  __builtin_amdgcn_s_setprio(0);
  { const float ltot = lrun + __shfl_xor(lrun, 32); const float inv = 1.0f / ltot;
    bf16* op = AO + (size_t)m * D + ((MODE < 2) ? 512 : 0) + h * 64;
#pragma unroll
    for (int eb = 0; eb < 2; ++eb)
#pragma unroll
      for (int gq = 0; gq < 4; ++gq) { const int e = eb * 32 + 8 * gq + 4 * hh;
        u32x2 wv; if (eb == 0) { wv.x = pk2(O0[4 * gq] * inv, O0[4 * gq + 1] * inv); wv.y = pk2(O0[4 * gq + 2] * inv, O0[4 * gq + 3] * inv); }
        else { wv.x = pk2(O1[4 * gq] * inv, O1[4 * gq + 1] * inv); wv.y = pk2(O1[4 * gq + 2] * inv, O1[4 * gq + 3] * inv); }
        *(u32x2*)(op + e) = wv; } }
  __syncthreads();
}

template <int LAT> DI void mla_item(const Ctx& c, int item) {
  constexpr int KS = 6, KLD = 104, VLD = 72, KBS = 13312, VB0 = 26624, VBS = 9216;
  const int r = c.lane & 31, hh = c.lane >> 5, w = c.wave;
  const bf16* Qb = (const bf16*)(c.ws + WS_BIG); const bf16* KVb = (const bf16*)(c.ws + WS_BIG + BIG_KV); const bf16* KPE = (const bf16*)(c.ws + WS_KPE);
  bf16* AO = (bf16*)(c.ws + WS_H);
  int b, h, g = 0, m, nt;
  if (!LAT) { b = item >> 4; h = item & 15; m = b * 256 + 32 * w + r; nt = 4; }
  else { b = item >> 7; h = (item >> 3) & 15; g = item & 7; m = NP + b * 2048 + g * 256 + 32 * w + r; nt = 36; }
  const float sc2 = 0.10206207261596577f * LOG2E;
  bf16x8 Qf[4]; bf16x8 Qp[2];
  const bf16* qrow = Qb + (size_t)m * 1536 + h * 96 + 8 * hh;
#pragma unroll
  for (int ks = 0; ks < 4; ++ks) Qf[ks] = *(const bf16x8*)(qrow + 16 * ks);
#pragma unroll
  for (int k2 = 0; k2 < 2; ++k2) Qp[k2] = *(const bf16x8*)(qrow + 64 + 16 * k2);
  if (LAT) { const float* RC = (const float*)(c.ws + WS_ROPE); const float* RS = RC + 32768; const int pos = g * 256 + 32 * w + r;
#pragma unroll
    for (int k2 = 0; k2 < 2; ++k2) { const f32x4 cs = *(const f32x4*)(RC + pos * 16 + 8 * k2 + 4 * hh), sn = *(const f32x4*)(RS + pos * 16 + 8 * k2 + 4 * hh);
      const u32x4 xw = __builtin_bit_cast(u32x4, Qp[k2]); u32x4 ow;
#pragma unroll
      for (int q = 0; q < 4; ++q) { const float x1 = bflo(xw[q]), x2 = bfhi(xw[q]); ow[q] = pk2(x1 * cs[q] - x2 * sn[q], x1 * sn[q] + x2 * cs[q]); }
      Qp[k2] = __builtin_bit_cast(bf16x8, ow); } }
  const int skey = c.tid >> 3, spart = c.tid & 7, pkey = (c.tid >> 2) & 63, ppart = c.tid & 3;
  const int vq = (c.lane & 15) >> 2, vcol = 16 * ((c.lane >> 4) & 1) + 4 * (c.lane & 3);
  u32x4 kregA = {0u, 0u, 0u, 0u}, vregA = {0u, 0u, 0u, 0u}, pregA = {0u, 0u, 0u, 0u}, kregB = {0u, 0u, 0u, 0u}, vregB = {0u, 0u, 0u, 0u}, pregB = {0u, 0u, 0u, 0u};
#define MROW(t) (LAT ? (((t) < 32) ? NP + b * 2048 + 64 * (t) : NT + b * 256 + 64 * ((t) - 32)) : b * 256 + 64 * (t))
#define LOADK(S, t) do { const int row_ = MROW(t); kreg##S = *(const u32x4*)(KVb + (size_t)(row_ + skey) * 2048 + h * 64 + spart * 8); if (c.tid < 256) preg##S = *(const u32x4*)(KPE + (size_t)(row_ + pkey) * 32 + ppart * 8); } while (0)
#define LOADV(S, t) do { const int row_ = MROW(t); vreg##S = *(const u32x4*)(KVb + (size_t)(row_ + skey) * 2048 + 1024 + h * 64 + spart * 8); } while (0)
#define STOREK(S, buf) do { LAS bf16* Ks_ = (LAS bf16*)(c.lds + (buf) * KBS); *(LAS u32x4*)(Ks_ + skey * KLD + spart * 8) = kreg##S; if (c.tid < 256) *(LAS u32x4*)(Ks_ + pkey * KLD + 64 + ppart * 8) = preg##S; } while (0)
#define STOREV(S, buf) do { LAS bf16* Vs_ = (LAS bf16*)(c.lds + VB0 + (buf) * VBS); *(LAS u32x4*)(Vs_ + skey * VLD + spart * 8) = vreg##S; } while (0)
#define QKT(d0, d1, buf) do { const LAS bf16* Ks_ = (const LAS bf16*)(c.lds + (buf) * KBS); d0 = zero16(); d1 = zero16(); \
    _Pragma("unroll") for (int ks = 0; ks < KS; ++ks) { const bf16x8 q_ = (ks < 4) ? Qf[ks & 3] : Qp[ks & 1]; \
      const bf16x8 A0_ = *(const LAS bf16x8*)(Ks_ + r * KLD + 16 * ks + 8 * hh); const bf16x8 A1_ = *(const LAS bf16x8*)(Ks_ + (32 + r) * KLD + 16 * ks + 8 * hh); \
      d0 = MFMA32(A0_, q_, d0); d1 = MFMA32(A1_, q_, d1); } } while (0)
#define PVT(buf) do { const LAS bf16* Vs_ = (const LAS bf16*)(c.lds + VB0 + (buf) * VBS); \
    _Pragma("unroll") for (int f = 0; f < 4; ++f) { const bf16x8 Pf_ = __builtin_bit_cast(bf16x8, pp[f]); const int vrow_ = 16 * f + 4 * hh + vq; \
      Ls = MFMA32(ones8, Pf_, Ls); \
      O0 = MFMA32(cat8(tr_read(Vs_ + vrow_ * VLD + vcol), tr_read(Vs_ + (vrow_ + 8) * VLD + vcol)), Pf_, O0); \
      O1 = MFMA32(cat8(tr_read(Vs_ + vrow_ * VLD + 32 + vcol), tr_read(Vs_ + (vrow_ + 8) * VLD + 32 + vcol)), Pf_, O1); } } while (0)
  LOADK(A, 0); LOADV(A, 0); LOADK(B, 1);
  STOREK(A, 0); STOREV(A, 0); STOREK(B, 1);
  LOADK(B, 2); LOADV(B, 1);
  __syncthreads();
  f32x16 c0, c1;
  QKT(c0, c1, 0);
  __syncthreads();
  f32x16 O0 = zero16(), O1 = zero16(), Ls = zero16();
  const bf16x8 ones8 = {(short)0x3f80, (short)0x3f80, (short)0x3f80, (short)0x3f80, (short)0x3f80, (short)0x3f80, (short)0x3f80, (short)0x3f80};
  float mrun = -1e30f;
  int vcur = 0, vnext = 1;
#define MLA_ITER(SL, SS) do { \
    { const int tk = min(t + 3, nt - 1), tv = min(t + 2, nt - 1); LOADK(SL, tk); LOADV(SL, tv); } \
    if (LAT && t + 1 == 32) { _Pragma("unroll") for (int k2 = 0; k2 < 2; ++k2) Qp[k2] = *(const bf16x8*)(qrow + 64 + 16 * k2); } \
    float tmax = -1e30f; \
    _Pragma("unroll") for (int reg = 0; reg < 16; ++reg) { tmax = fmax_nc(tmax, c0[reg]); tmax = fmax_nc(tmax, c1[reg]); } \
    tmax = fmaxf(tmax, __shfl_xor(tmax, 32)); \
    const float tm = tmax * sc2; \
    if (__builtin_amdgcn_ballot_w64(tm > mrun + 8.0f) != 0ull) { \
      const float mnew = fmaxf(mrun, tm); const float alpha = __builtin_amdgcn_exp2f(mrun - mnew); mrun = mnew; \
      _Pragma("unroll") for (int reg = 0; reg < 16; ++reg) { O0[reg] *= alpha; O1[reg] *= alpha; Ls[reg] *= alpha; } } \
    f32x16 n0, n1; \
    QKT(n0, n1, (t + 1) & 1); \
    _Pragma("unroll") for (int reg = 0; reg < 16; ++reg) { c0[reg] = __builtin_amdgcn_exp2f(fmaf(c0[reg], sc2, -mrun)); c1[reg] = __builtin_amdgcn_exp2f(fmaf(c1[reg], sc2, -mrun)); } \
    u32x4 pp[4]; \
    _Pragma("unroll") for (int sp = 0; sp < 2; ++sp) { \
      pp[sp] = (u32x4){pk2(c0[8 * sp + 0], c0[8 * sp + 1]), pk2(c0[8 * sp + 2], c0[8 * sp + 3]), pk2(c0[8 * sp + 4], c0[8 * sp + 5]), pk2(c0[8 * sp + 6], c0[8 * sp + 7])}; \
      pp[2 + sp] = (u32x4){pk2(c1[8 * sp + 0], c1[8 * sp + 1]), pk2(c1[8 * sp + 2], c1[8 * sp + 3]), pk2(c1[8 * sp + 4], c1[8 * sp + 5]), pk2(c1[8 * sp + 6], c1[8 * sp + 7])}; } \
    PVT(vcur); \
    c0 = n0; c1 = n1; \
    STOREK(SS, t & 1); STOREV(SS, vnext); \
    { const int nv = (vnext == 2) ? 0 : vnext + 1; vcur = vnext; vnext = nv; } \
    __syncthreads(); } while (0)
  if (w >= 4) __builtin_amdgcn_s_setprio(1);
  for (int t = 0; t < nt; t += 2) {
    MLA_ITER(A, B);
    ++t;
    MLA_ITER(B, A);
    --t;
  }
#undef MLA_ITER
  __builtin_amdgcn_s_setprio(0);
  { const float inv = 1.0f / Ls[0];
    bf16* op = AO + (size_t)m * D + h * 64;
#pragma unroll
    for (int eb = 0; eb < 2; ++eb)
#pragma unroll
      for (int gq = 0; gq < 4; ++gq) { const int e = eb * 32 + 8 * gq + 4 * hh;
        u32x2 wv; if (eb == 0) { wv.x = pk2(O0[4 * gq] * inv, O0[4 * gq + 1] * inv); wv.y = pk2(O0[4 * gq + 2] * inv, O0[4 * gq + 3] * inv); }
        else { wv.x = pk2(O1[4 * gq] * inv, O1[4 * gq + 1] * inv); wv.y = pk2(O1[4 * gq + 2] * inv, O1[4 * gq + 3] * inv); }
        *(u32x2*)(op + e) = wv; } }
  __syncthreads();
#undef MROW
#undef LOADK
#undef LOADV
#undef STOREK
#undef STOREV
#undef QKT
#undef PVT
}

#define XB_TMO      128
#define XB_XCNT(j)  (256  + 64 * (j))
#define XB_XSUB(j)  (1280 + 64 * (j))
#define XB_XGEN(j)  (2304 + 64 * (j))
#define XB_TOP      3328
#define XB_TOPGEN   3392
#define XCD_BAR_WORDS 3456
#define XB_SPIN_CAP (1u << 18)
DI unsigned xb_ld(unsigned* p)              { return __hip_atomic_load(p, __ATOMIC_RELAXED, __HIP_MEMORY_SCOPE_AGENT); }
DI unsigned xb_add(unsigned* p, unsigned v) { return __hip_atomic_fetch_add(p, v, __ATOMIC_RELAXED, __HIP_MEMORY_SCOPE_AGENT); }
DI unsigned xb_xcc_id() { return (unsigned)__builtin_amdgcn_s_getreg((3 << 11) | 20) & 0xFu; }
#define XB_SPIN(cond, bar) do { unsigned _sp = 0; while (cond) { __builtin_amdgcn_s_sleep(1); \
    if ((++_sp & 255u) == 0u) { if (xb_ld(&(bar)[XB_TMO])) break; if (_sp > XB_SPIN_CAP) { atomicAdd(&(bar)[XB_TMO], 1u); break; } } } } while (0)
struct XcdBarrier { unsigned* bar; unsigned x; volatile LAS unsigned* st; };
DI void xcd_barrier_post(unsigned* bar) { if (threadIdx.x == 0) (void)xb_add(&bar[XB_XCNT(xb_xcc_id())], 1u); }
DI void xcd_barrier_complete(unsigned* bar, unsigned x, unsigned& nloc, unsigned& nx) {
  const unsigned G = gridDim.x * gridDim.y * gridDim.z;
  unsigned sum, cnt, mine, sp = 0u;
  for (;;) {
    sum = 0u; cnt = 0u; mine = 0u;
#pragma unroll
    for (unsigned j = 0; j < 16; ++j) { const unsigned c = xb_ld(&bar[XB_XCNT(j)]); sum += c; cnt += (c > 0u) ? 1u : 0u; mine = (j == x) ? c : mine; }
    if (sum == G) break;
    __builtin_amdgcn_s_sleep(1);
    if ((++sp & 255u) == 0u) { if (xb_ld(&bar[XB_TMO])) break; if (sp > XB_SPIN_CAP) { atomicAdd(&bar[XB_TMO], 1u); break; } }
  }
  nloc = mine > 0u ? mine : 1u; nx = cnt > 0u ? cnt : 1u;
}
DI void xcd_barrier(const XcdBarrier& b) {
  asm volatile("s_waitcnt vmcnt(0)" ::: "memory");
  __syncthreads();
  if (threadIdx.x == 0) {
    unsigned* bar = b.bar;
    __builtin_amdgcn_s_waitcnt(0);
    unsigned nloc = b.st[0], nx = b.st[1];
    if (nloc == 0u) { xcd_barrier_complete(bar, b.x, nloc, nx); b.st[0] = nloc; b.st[1] = nx; }
    const unsigned old = xb_add(&bar[XB_XSUB(b.x)], 1u);
    const unsigned gen = old / nloc;
    if (old + 1u == (gen + 1u) * nloc) {
      __builtin_amdgcn_fence(__ATOMIC_RELEASE, "agent");
      asm volatile("s_waitcnt vmcnt(0)" ::: "memory");
      const unsigned og = xb_add(&bar[XB_TOP], 1u);
      const unsigned tg = og / nx;
      if (og + 1u == (tg + 1u) * nx) xb_add(&bar[XB_TOPGEN], 1u);
      else XB_SPIN(xb_ld(&bar[XB_TOPGEN]) == tg, bar);
      __builtin_amdgcn_fence(__ATOMIC_ACQUIRE, "agent");
      xb_add(&bar[XB_XGEN(b.x)], 1u);
      asm volatile("s_waitcnt vmcnt(0)" ::: "memory");
    } else {
      XB_SPIN(xb_ld(&bar[XB_XGEN(b.x)]) == gen, bar);
      __builtin_amdgcn_fence(__ATOMIC_ACQUIRE, "agent");
      asm volatile("s_waitcnt vmcnt(0)" ::: "memory");
    }
  }
  __syncthreads();
}
constexpr size_t WS_BAR = 65536;
constexpr int LDS_BARST = 139264;

#ifdef PROBE_MASK
#define TICK(slot) do { if (blockIdx.x == 0 && threadIdx.x == 0) { volatile unsigned long long* tw_ = (volatile unsigned long long*)a.ws; const unsigned long long now_ = __builtin_amdgcn_s_memrealtime(); \
    if ((PROBE_MASK >> (slot)) & 1) tw_[1] = tw_[1] + (now_ - tw_[0]); tw_[0] = now_; } } while (0)
#else
#define TICK(slot) do { } while (0)
#endif
#define RFL64(p) (((unsigned long long)(unsigned)__builtin_amdgcn_readfirstlane((int)((unsigned long long)(p) >> 32)) << 32) | (unsigned long long)(unsigned)__builtin_amdgcn_readfirstlane((int)(unsigned)(unsigned long long)(p)))
#define XSYNC1() do { XcdBarrier xb_; { unsigned long long bp_ = RFL64(a.ws + WS_BAR); asm volatile("" : "+s"(bp_)); xb_.bar = (unsigned*)(__attribute__((address_space(1))) unsigned*)bp_; } xb_.x = xb_xcc_id(); xb_.st = (volatile LAS unsigned*)((lptr)lds_raw + LDS_BARST); xcd_barrier(xb_); } while (0)
#ifdef DOUBLE_SYNC
#define GSYNC() do { XSYNC1(); XSYNC1(); } while (0)
#else
#define GSYNC() XSYNC1()
#endif
__global__ void __launch_bounds__(512, 2) mk_fwd(Args a) {
  extern __shared__ __attribute__((aligned(16))) unsigned char lds_raw[];
  cg::grid_group grid = cg::this_grid();
  const int wave0 = __builtin_amdgcn_readfirstlane((int)(threadIdx.x >> 6));
#define MAKE_CTX() Ctx c; { unsigned long long wsp_ = RFL64(a.ws), outp_ = RFL64(a.out); int z_ = 0; int lane_; int g_ = __builtin_amdgcn_readfirstlane((int)gridDim.x), b_ = __builtin_amdgcn_readfirstlane((int)blockIdx.x); \
    asm volatile("v_mbcnt_lo_u32_b32 %0, -1, 0\n\tv_mbcnt_hi_u32_b32 %0, -1, %0" : "=v"(lane_)); \
    asm volatile("" : "+s"(wsp_), "+s"(outp_), "+s"(z_), "+s"(g_), "+s"(b_)); const int tid_ = wave0 * 64 + lane_; \
    c.in = a.in + z_; c.out = (float*)(__attribute__((address_space(1))) float*)outp_; c.ws = (unsigned char*)(__attribute__((address_space(1))) unsigned char*)wsp_; c.lds = (lptr)lds_raw; c.tid = tid_; c.lane = lane_; c.wave = wave0; c.G = g_; c.bid = b_; c.zero = z_; } \
    unsigned char* ws = c.ws; bf16* Hb = (bf16*)(ws + WS_H); float* Yb = (float*)(ws + WS_Y); unsigned char* BIG = ws + WS_BIG; unsigned char* WA = ws + WS_WA; (void)Hb; (void)Yb; (void)BIG; (void)WA;
  if (threadIdx.x < 4) ((LAS unsigned*)((lptr)lds_raw + LDS_BARST))[threadIdx.x] = 0u;
  __syncthreads();
  xcd_barrier_post((unsigned*)(a.ws + WS_BAR));
#ifdef PROBE_MASK
  if (blockIdx.x == 0 && threadIdx.x == 0) { volatile unsigned long long* tw_ = (volatile unsigned long long*)a.ws; tw_[1] = 0ull; tw_[0] = __builtin_amdgcn_s_memrealtime(); }
#endif
#if !defined(PHASE_MASK) || (PHASE_MASK & 1)
  { MAKE_CTX(); prologue(c); }
  if (a.use_cg) grid.sync(); else GSYNC();
  { MAKE_CTX(); row_phase(c, 0, 0); }
  GSYNC();
  TICK(0);
#endif

  for (int l = 0; l < 4; ++l) {
    const int odd = l & 1, hl = l >> 1;
    const unsigned long long prog = odd ? 0x7C65BA984ull : 0x7C65B321ull;
    for (int st = 0; st < 9; ++st) {
      const int op = (int)((prog >> (4 * st)) & 15ull);
      if (op == 0) break;
#ifdef PHASE_MASK
      if (!((PHASE_MASK >> op) & 1)) continue;
#endif
      if (op == 1) { MAKE_CTX();
        pg8::Gemm g{Hb, (const bf16*)WA, NT, ACIN, D, D, D, ACIN / 256}; pg8::StaticOrder S; S.init(NT, ACIN, c.G, c.bid);
        pg8::EpiBf16<2> E{(bf16*)BIG, ACIN, c.out + O_NK + (size_t)hl * 8 * 256 * 64, c.out + O_NV + (size_t)hl * 8 * 256 * 64};
        pg8::gemm_phase(c.lds, g, S, E, c.tid);
      } else if (op == 2) { MAKE_CTX();
        const int vb = (c.G % 8 == 0) ? (c.bid % 8) * (c.G / 8) + c.bid / 8 : c.bid;
        for (int it = vb; it < 768 + 256 + 512; it += c.G) {
          if (it < 768) ret_kv_item(c, it, hl);
          else if (it < 1024) attn_item<0>(c, it - 768, hl);
          else attn_item<1>(c, it - 1024, hl);
        }
      } else if (op == 3) { MAKE_CTX();
        const int vb = (c.G % 8 == 0) ? (c.bid % 8) * (c.G / 8) + c.bid / 8 : c.bid;
        for (int it = vb; it < 768; it += c.G) ret_out_item(c, it, hl);
      } else if (op == 4) { MAKE_CTX();
        pg8::Gemm g{Hb, (const bf16*)WA, NT, CINP, D, D, D, CINP / 256}; pg8::EpiF32 E{(float*)BIG, CINP};
        pg8::StaticOrder S; S.init(g.M, g.N, c.G, c.bid);
        pg8::gemm_phase(c.lds, g, S, E, c.tid);
      } else if (op == 5) { MAKE_CTX();
        row_phase(c, l, 1);
      } else if (op == 6) { MAKE_CTX();
        pg8::Gemm g{Hb, (const bf16*)(ws + WS_W1T), NT, FF, D, D, D, FF / 256}; pg8::StaticOrder S; S.init(NT, FF, c.G, c.bid);
        pg8::EpiBf16<1> E{(bf16*)BIG, FF, nullptr, nullptr};
        pg8::gemm_phase(c.lds, g, S, E, c.tid);
      } else if (op == 7) { MAKE_CTX();
        row_phase(c, l, 2);
        if (l < 3) convert_weights(c, l + 1);
      } else if (op == 8) { MAKE_CTX();
        mla_rows(c, hl);
      } else if (op == 9 || op == 11 || op == 12) { MAKE_CTX();
        const int njobs = (op == 9) ? 2 : 1;
        for (int j = 0; j < njobs; ++j) {
          pg8::Gemm g; pg8::EpiBf16<0> E;
          if (op == 9) {
            if (j) { g = pg8::Gemm{(const bf16*)(ws + WS_H + H_CKVN), (const bf16*)(WA + WA_UKV), NT + NCTX, 2048, 256, 256, 256, 8}; E = pg8::EpiBf16<0>{(bf16*)(BIG + BIG_KV), 2048, nullptr, nullptr}; }
            else { g = pg8::Gemm{Hb, (const bf16*)(WA + WA_UQ), NT, 1536, 384, 384, 384, 6}; E = pg8::EpiBf16<0>{(bf16*)BIG, 1536, nullptr, nullptr}; }
          } else if (op == 11) { g = pg8::Gemm{Hb, (const bf16*)(WA + (odd ? WA_OUT_O : WA_OUT_E)), NT, D, D, D, D, 4}; E = pg8::EpiBf16<0>{(bf16*)Yb, D, nullptr, nullptr};
          } else { g = pg8::Gemm{(const bf16*)BIG, (const bf16*)(ws + WS_W2T), NT, 2 * D, FF / 2, FF, FF, 4}; E = pg8::EpiBf16<0>{(bf16*)Yb, 2 * D, nullptr, nullptr}; }
          pg8::StaticOrder S; S.init(g.M, g.N, c.G, (op == 9 && j) ? (c.bid + 3 * c.G / 4) % c.G : c.bid);
          pg8::gemm_phase(c.lds, g, S, E, c.tid);
        }
      } else if (op == 10) { MAKE_CTX();
        const int vb = (c.G % 8 == 0) ? (c.bid % 8) * (c.G / 8) + c.bid / 8 : c.bid;
        for (int it = vb; it < 512 + 1024; it += c.G) {
          if (it < 512) mla_item<0>(c, it); else mla_item<1>(c, it - 512);
        }
      }
      GSYNC();
      TICK(op);
    }
  }
#ifdef PROBE_MASK
  if (blockIdx.x == 0 && threadIdx.x == 0) { volatile unsigned long long* tw_ = (volatile unsigned long long*)a.ws; const unsigned long long wait_ = tw_[1] * 10ull, t0_ = __builtin_amdgcn_s_memrealtime();
    while (__builtin_amdgcn_s_memrealtime() - t0_ < wait_) __builtin_amdgcn_s_sleep(8); }
#endif
}

extern "C" void kernel_launch(void* const* d_in, const int* in_sizes, int n_in, void* d_out, int out_size, void* d_ws, size_t ws_size, hipStream_t stream) {
  static int grid = 0;
  if (grid == 0) {
    if (n_in != 27 || out_size != 50855936 || ws_size < WS_END) { fprintf(stderr, "kernel_launch: unexpected shapes (n_in %d out %d ws %zu)\n", n_in, out_size, ws_size); grid = -1; return; }
    int dev = 0, cus = 0, per_cu = 0;
    if (hipGetDevice(&dev) != hipSuccess || hipDeviceGetAttribute(&cus, hipDeviceAttributeMultiprocessorCount, dev) != hipSuccess) { grid = -1; return; }
    if (hipFuncSetAttribute((const void*)mk_fwd, hipFuncAttributeMaxDynamicSharedMemorySize, LDS_BYTES) != hipSuccess) { fprintf(stderr, "kernel_launch: hipFuncSetAttribute failed\n"); grid = -1; return; }
    if (hipOccupancyMaxActiveBlocksPerMultiprocessor(&per_cu, (const void*)mk_fwd, 512, LDS_BYTES) != hipSuccess || per_cu < 1) { fprintf(stderr, "kernel_launch: occupancy query says %d\n", per_cu); per_cu = 1; }
    (void)hipGetLastError();
    grid = cus;
  }
  if (grid < 0) return;
  Args a{};
  for (int i = 0; i < 27; ++i) a.in[i] = (const float*)d_in[i];
  a.out = (float*)d_out; a.ws = (unsigned char*)d_ws;
  if (hipMemsetAsync((char*)d_ws + WS_BAR, 0, 16384, stream) != hipSuccess) { fprintf(stderr, "kernel_launch: memset failed\n"); return; }
  void* args[] = {&a};
  hipError_t e = hipLaunchCooperativeKernel((const void*)mk_fwd, dim3(grid), dim3(512), args, LDS_BYTES, stream);
  if (e != hipSuccess) fprintf(stderr, "kernel_launch: cooperative launch failed: %s\n", hipGetErrorString(e));
}
```
